# Optimizing an MI355X kernel written in HIP

```python
import math
import jax
import jax.numpy as jnp
from jax import lax
import numpy as np

D_MODEL = 1024
BATCH = 4
SEQ = 4096
DEPTH = 2

RMS_EPS = 1e-6
ROPE_THETA = 500000.0

SSD_HEAD_DIM = 64
SSD_D_INNER = D_MODEL
SSD_HEADS = SSD_D_INNER // SSD_HEAD_DIM
SSD_GROUPS = 4
SSD_D_STATE = 128
SSD_CONV = 4
SSD_CHUNK = 256
SSD_CONV_DIM = SSD_D_INNER + 2 * SSD_GROUPS * SSD_D_STATE

DIL_PAIRS = ((128, 1), (512, 4), (2048, 16))
DIL_HEAD_DIM = 64
DIL_HEADS_PER_GROUP = 8
DIL_HEADS = DIL_HEADS_PER_GROUP * len(DIL_PAIRS)
DIL_QKV = DIL_HEADS * DIL_HEAD_DIM
DIL_OUT = DIL_HEADS_PER_GROUP * DIL_HEAD_DIM

MOBA_HEAD_DIM = 64
MOBA_WIDTH = D_MODEL
MOBA_HEADS = MOBA_WIDTH // MOBA_HEAD_DIM
MOBA_BLOCK = 256
MOBA_TOPK = 3
MOBA_Q_CHUNK = 16

EVEN_IN_SIZES = (SSD_D_INNER, SSD_CONV_DIM, SSD_HEADS, DIL_QKV, DIL_QKV, DIL_QKV, DIL_OUT)
EVEN_IN = sum(EVEN_IN_SIZES)
EVEN_MIX = SSD_D_INNER + DIL_OUT
ODD_IN = 4 * MOBA_WIDTH
N_EVEN = (DEPTH + 1) // 2
N_ODD = DEPTH // 2

kernel_name = "hybrid_ssd_dilated_moba_trunk"


def rms_norm(x, w):
    xf = x.astype(jnp.float32)
    y = xf * lax.rsqrt(jnp.mean(xf * xf, axis=-1, keepdims=True) + RMS_EPS)
    return (y * w.astype(jnp.float32)).astype(x.dtype)


def partial_rope(x, pos):
    e = x.shape[-1]
    rd = e // 4
    half = rd // 2
    inv = ROPE_THETA ** (-jnp.arange(half, dtype=jnp.float32) * 2.0 / rd)
    ang = pos.astype(jnp.float32)[:, None] * inv[None, :]
    cos = jnp.cos(ang)[:, None, :]
    sin = jnp.sin(ang)[:, None, :]
    xr = x[..., :rd].astype(jnp.float32)
    x1, x2 = xr[..., :half], xr[..., half:]
    rot = jnp.concatenate([x1 * cos - x2 * sin, x2 * cos + x1 * sin], axis=-1)
    return jnp.concatenate([rot.astype(x.dtype), x[..., rd:]], axis=-1)


def split_cols(t, sizes):
    outs, o = [], 0
    for s in sizes:
        outs.append(t[..., o:o + s])
        o += s
    return outs


def causal_dwconv(x, w, b):
    K = w.shape[1]
    rhs = jnp.transpose(w)[:, None, :].astype(x.dtype)
    y = lax.conv_general_dilated(x, rhs, window_strides=(1,), padding=((K - 1, 0),),
                                 dimension_numbers=("NWC", "WIO", "NWC"),
                                 feature_group_count=x.shape[-1])
    return y + b.astype(x.dtype)


def segsum(a):
    T = a.shape[-1]
    cs = jnp.cumsum(a, axis=-1)
    diff = cs[..., :, None] - cs[..., None, :]
    mask = jnp.tril(jnp.ones((T, T), dtype=bool))
    return jnp.where(mask, diff, -jnp.inf)


def ssd_chunked_scan(x, dt, A, Bm, Cm):
    Bsz, S, H, P = x.shape
    G, N = Bm.shape[2], Bm.shape[3]
    J = H // G
    L = SSD_CHUNK
    pad = (-S) % L
    xdt = x.astype(jnp.float32) * dt[..., None]
    a = dt * A
    Bf = Bm.astype(jnp.float32)
    Cf = Cm.astype(jnp.float32)
    if pad:
        padseq = lambda t: jnp.pad(t, [(0, 0), (0, pad)] + [(0, 0)] * (t.ndim - 2))
        xdt, a, Bf, Cf = padseq(xdt), padseq(a), padseq(Bf), padseq(Cf)
    nc = (S + pad) // L
    xdt = xdt.reshape(Bsz, nc, L, G, J, P)
    Bc = Bf.reshape(Bsz, nc, L, G, N)
    Cc = Cf.reshape(Bsz, nc, L, G, N)
    a = a.reshape(Bsz, nc, L, G, J).transpose(0, 3, 4, 1, 2)
    a_cs = jnp.cumsum(a, axis=-1)
    cb = jnp.einsum("bclgn,bcsgn->bgcls", Cc, Bc)
    m = cb[:, :, None] * jnp.exp(segsum(a))
    y_diag = jnp.einsum("bgjcls,bcsgjp->bclgjp", m, xdt)
    w_end = jnp.exp(a_cs[..., -1:] - a_cs).transpose(0, 3, 4, 1, 2)
    states = jnp.einsum("bclgn,bclgjp->bcgjpn", Bc, xdt * w_end[..., None])
    a_last = jnp.pad(a_cs[..., -1], [(0, 0)] * 3 + [(1, 0)])
    decay_chunk = jnp.exp(segsum(a_last))
    states0 = jnp.concatenate([jnp.zeros_like(states[:, :1]), states], axis=1)
    entering = jnp.einsum("bgjzc,bcgjpn->bzgjpn", decay_chunk, states0)[:, :-1]
    w_start = jnp.exp(a_cs).transpose(0, 3, 4, 1, 2)
    y_off = jnp.einsum("bclgn,bcgjpn->bclgjp", Cc, entering) * w_start[..., None]
    return (y_diag + y_off).reshape(Bsz, nc * L, H, P)[:, :S]


def dilated_group(q, k, v, window, dil):
    Bsz, S, h, e = q.shape
    band = window // dil
    Lsub = S // dil
    nb = -(-Lsub // band)
    Lp = nb * band

    def to_sub(t):
        t = t.astype(jnp.float32).reshape(Bsz, Lsub, dil, h, e).transpose(0, 3, 2, 1, 4)
        t = jnp.pad(t, ((0, 0), (0, 0), (0, 0), (0, Lp - Lsub), (0, 0)))
        return t.reshape(Bsz, h, dil, nb, band, e)

    def with_prev(t):
        prev = jnp.pad(t, ((0, 0), (0, 0), (0, 0), (1, 0), (0, 0), (0, 0)))[:, :, :, :-1]
        return jnp.concatenate([prev, t], axis=4)

    qs = to_sub(q)
    kb = with_prev(to_sub(k))
    vb = with_prev(to_sub(v))
    s = jnp.einsum("bhrnqe,bhrnke->bhrnqk", qs, kb) * (e ** -0.5)
    i = jnp.arange(band)[:, None]
    j = jnp.arange(2 * band)[None, :]
    dist = i + band - j
    n = jnp.arange(nb)[:, None, None]
    valid = (dist >= 0) & (dist <= band) & ((n * band + j[None] - band) >= 0)
    s = jnp.where(valid, s, -jnp.inf)
    mx = jnp.max(s, axis=-1, keepdims=True)
    p = jnp.exp(s - mx)
    den = jnp.sum(p, axis=-1)
    o = jnp.einsum("bhrnqk,bhrnke->bhrnqe", p, vb) / den[..., None]
    lse = mx[..., 0] + jnp.log(den)
    o = o.reshape(Bsz, h, dil, Lp, e)[:, :, :, :Lsub].transpose(0, 3, 2, 1, 4).reshape(Bsz, S, h, e)
    lse = lse.reshape(Bsz, h, dil, Lp)[:, :, :, :Lsub].transpose(0, 3, 2, 1).reshape(Bsz, S, h)
    return o, lse


def moba_attention(q, k, v):
    Bsz, S, H, e = q.shape
    blk = MOBA_BLOCK
    nblk = -(-S // blk)
    Sp = nblk * blk
    scale = e ** -0.5

    def heads_first(t):
        t = t.astype(jnp.float32).transpose(0, 2, 1, 3)
        return jnp.pad(t, ((0, 0), (0, 0), (0, Sp - S), (0, 0)))

    qh = heads_first(q)
    kb = heads_first(k).reshape(Bsz, H, nblk, blk, e)
    vb = heads_first(v).reshape(Bsz, H, nblk, blk, e)
    kmean = jnp.mean(kb, axis=3)
    gate = jnp.einsum("bhte,bhne->bhtn", qh, kmean)
    tblk = jnp.arange(Sp) // blk
    past = jnp.arange(nblk)[None, :] < tblk[:, None]
    gate = jnp.where(past, gate, -jnp.inf)
    ksel = min(MOBA_TOPK, nblk)
    _, sel = lax.top_k(gate, ksel)
    sel_valid = sel < tblk[:, None]

    Qc = MOBA_Q_CHUNK
    nq = Sp // Qc
    qc = qh.reshape(Bsz, H, nq, Qc, e).transpose(2, 0, 1, 3, 4)
    selc = sel.reshape(Bsz, H, nq, Qc, ksel).transpose(2, 0, 1, 3, 4)
    valc = sel_valid.reshape(Bsz, H, nq, Qc, ksel).transpose(2, 0, 1, 3, 4)
    bi = jnp.arange(Bsz)[:, None, None, None]
    hi = jnp.arange(H)[None, :, None, None]

    def one_chunk(args):
        c, q_c, sel_c, val_c = args
        own = (c * Qc) // blk
        k_sel = kb[bi, hi, sel_c]
        v_sel = vb[bi, hi, sel_c]
        s_sel = jnp.einsum("bhqe,bhqjke->bhqjk", q_c, k_sel) * scale
        s_sel = jnp.where(val_c[..., None], s_sel, -jnp.inf).reshape(Bsz, H, Qc, ksel * blk)
        k_own = lax.dynamic_index_in_dim(kb, own, axis=2, keepdims=False)
        v_own = lax.dynamic_index_in_dim(vb, own, axis=2, keepdims=False)
        s_own = jnp.einsum("bhqe,bhke->bhqk", q_c, k_own) * scale
        qpos = c * Qc + jnp.arange(Qc)
        kpos = own * blk + jnp.arange(blk)
        s_own = jnp.where(kpos[None, :] <= qpos[:, None], s_own, -jnp.inf)
        p = jax.nn.softmax(jnp.concatenate([s_sel, s_own], axis=-1), axis=-1)
        p_sel = p[..., :ksel * blk].reshape(Bsz, H, Qc, ksel, blk)
        return (jnp.einsum("bhqjk,bhqjke->bhqe", p_sel, v_sel)
                + jnp.einsum("bhqk,bhke->bhqe", p[..., ksel * blk:], v_own))

    out = lax.map(one_chunk, (jnp.arange(nq), qc, selc, valc))
    return out.transpose(1, 0, 3, 2, 4).reshape(Bsz, Sp, H, e)[:, :S]


def ssd_dilated_layer(x, norm_w, w_in, conv_w, conv_b, dt_bias, a_log, d_skip, ssd_norm_w,
                      q_norm, k_norm, w_out, pos):
    Bsz, S, _ = x.shape
    h = rms_norm(x, norm_w)
    proj = jnp.einsum("bsd,df->bsf", h, w_in.astype(h.dtype))
    z, xbc, dt, q, k, v, g = split_cols(proj, EVEN_IN_SIZES)
    xbc = jax.nn.silu(causal_dwconv(xbc, conv_w, conv_b))
    xs, bm, cm = split_cols(xbc, (SSD_D_INNER, SSD_GROUPS * SSD_D_STATE, SSD_GROUPS * SSD_D_STATE))
    xs = xs.reshape(Bsz, S, SSD_HEADS, SSD_HEAD_DIM)
    dt = jax.nn.softplus(dt.astype(jnp.float32) + dt_bias.astype(jnp.float32))
    A = -jnp.exp(a_log.astype(jnp.float32))
    y = ssd_chunked_scan(xs, dt, A, bm.reshape(Bsz, S, SSD_GROUPS, SSD_D_STATE),
                         cm.reshape(Bsz, S, SSD_GROUPS, SSD_D_STATE))
    y = y + d_skip.astype(jnp.float32)[:, None] * xs.astype(jnp.float32)
    y = y.reshape(Bsz, S, SSD_D_INNER) * jax.nn.silu(z.astype(jnp.float32))
    y = rms_norm(y.reshape(Bsz, S, SSD_GROUPS, -1),
                 ssd_norm_w.reshape(SSD_GROUPS, -1)).reshape(Bsz, S, SSD_D_INNER)
    q = partial_rope(rms_norm(q.reshape(Bsz, S, DIL_HEADS, DIL_HEAD_DIM), q_norm), pos)
    k = partial_rope(rms_norm(k.reshape(Bsz, S, DIL_HEADS, DIL_HEAD_DIM), k_norm), pos)
    v = v.reshape(Bsz, S, DIL_HEADS, DIL_HEAD_DIM)
    outs, lses = [], []
    for gi, (window, dil) in enumerate(DIL_PAIRS):
        hs = slice(gi * DIL_HEADS_PER_GROUP, (gi + 1) * DIL_HEADS_PER_GROUP)
        o_g, lse_g = dilated_group(q[:, :, hs], k[:, :, hs], v[:, :, hs], window, dil)
        outs.append(o_g)
        lses.append(lse_g)
    wts = jax.nn.softmax(jnp.stack(lses, axis=0), axis=0)
    o = jnp.sum(wts[..., None] * jnp.stack(outs, axis=0), axis=0)
    o = o.reshape(Bsz, S, DIL_OUT) * jax.nn.silu(g.astype(jnp.float32))
    mixed = jnp.concatenate([y.astype(jnp.float32), o], axis=-1).astype(x.dtype)
    return x + jnp.einsum("bsf,fd->bsd", mixed, w_out.astype(x.dtype))


def moba_layer(x, norm_w, w_in, q_norm, k_norm, w_out, pos):
    Bsz, S, _ = x.shape
    h = rms_norm(x, norm_w)
    proj = jnp.einsum("bsd,df->bsf", h, w_in.astype(h.dtype))
    q, k, v, g = split_cols(proj, (MOBA_WIDTH,) * 4)
    q = partial_rope(rms_norm(q.reshape(Bsz, S, MOBA_HEADS, MOBA_HEAD_DIM), q_norm), pos)
    k = partial_rope(rms_norm(k.reshape(Bsz, S, MOBA_HEADS, MOBA_HEAD_DIM), k_norm), pos)
    v = v.reshape(Bsz, S, MOBA_HEADS, MOBA_HEAD_DIM)
    o = moba_attention(q, k, v).reshape(Bsz, S, MOBA_WIDTH) * jax.nn.silu(g.astype(jnp.float32))
    return x + jnp.einsum("bsf,fd->bsd", o.astype(x.dtype), w_out.astype(x.dtype))


def setup_inputs(seed: int = 0) -> dict:
    key = jax.random.key(seed)
    ks = jax.random.split(key, 20)
    f32 = jnp.float32
    nrm = lambda k, shape, s: jax.random.normal(k, shape, f32) * s
    x = jax.random.normal(ks[0], (BATCH, SEQ, D_MODEL), f32)
    even_norm_w = 1.0 + nrm(ks[1], (N_EVEN, D_MODEL), 0.05)
    even_w_in = nrm(ks[2], (N_EVEN, D_MODEL, EVEN_IN), D_MODEL ** -0.5)
    even_conv_w = nrm(ks[3], (N_EVEN, SSD_CONV_DIM, SSD_CONV), SSD_CONV ** -0.5)
    even_conv_b = nrm(ks[4], (N_EVEN, SSD_CONV_DIM), 0.01)
    dt0 = jnp.exp(jax.random.uniform(ks[5], (N_EVEN, SSD_HEADS), f32,
                                     math.log(1e-3), math.log(1e-1)))
    even_dt_bias = dt0 + jnp.log(-jnp.expm1(-dt0))
    even_a_log = jnp.log(jax.random.uniform(ks[6], (N_EVEN, SSD_HEADS), f32, 1.0, 16.0))
    even_d_skip = 1.0 + nrm(ks[7], (N_EVEN, SSD_HEADS), 0.1)
    even_ssd_norm_w = 1.0 + nrm(ks[8], (N_EVEN, SSD_D_INNER), 0.05)
    even_q_norm = 1.0 + nrm(ks[9], (N_EVEN, DIL_HEAD_DIM), 0.05)
    even_k_norm = 1.0 + nrm(ks[10], (N_EVEN, DIL_HEAD_DIM), 0.05)
    even_w_out = nrm(ks[11], (N_EVEN, EVEN_MIX, D_MODEL), EVEN_MIX ** -0.5)
    odd_norm_w = 1.0 + nrm(ks[12], (N_ODD, D_MODEL), 0.05)
    odd_w_in = nrm(ks[13], (N_ODD, D_MODEL, ODD_IN), D_MODEL ** -0.5)
    odd_q_norm = 1.0 + nrm(ks[14], (N_ODD, MOBA_HEAD_DIM), 0.05)
    odd_k_norm = 1.0 + nrm(ks[15], (N_ODD, MOBA_HEAD_DIM), 0.05)
    odd_w_out = nrm(ks[16], (N_ODD, MOBA_WIDTH, D_MODEL), MOBA_WIDTH ** -0.5)
    return {"x": x, "even_norm_w": even_norm_w, "even_w_in": even_w_in,
            "even_conv_w": even_conv_w, "even_conv_b": even_conv_b,
            "even_dt_bias": even_dt_bias, "even_a_log": even_a_log, "even_d_skip": even_d_skip,
            "even_ssd_norm_w": even_ssd_norm_w, "even_q_norm": even_q_norm,
            "even_k_norm": even_k_norm, "even_w_out": even_w_out,
            "odd_norm_w": odd_norm_w, "odd_w_in": odd_w_in, "odd_q_norm": odd_q_norm,
            "odd_k_norm": odd_k_norm, "odd_w_out": odd_w_out}


def reference(x, even_norm_w, even_w_in, even_conv_w, even_conv_b, even_dt_bias, even_a_log,
              even_d_skip, even_ssd_norm_w, even_q_norm, even_k_norm, even_w_out,
              odd_norm_w, odd_w_in, odd_q_norm, odd_k_norm, odd_w_out):
    pos = jnp.arange(x.shape[1], dtype=jnp.int32)
    for layer in range(DEPTH):
        li = layer // 2
        if layer % 2 == 0:
            x = ssd_dilated_layer(x, even_norm_w[li], even_w_in[li], even_conv_w[li],
                                  even_conv_b[li], even_dt_bias[li], even_a_log[li],
                                  even_d_skip[li], even_ssd_norm_w[li], even_q_norm[li],
                                  even_k_norm[li], even_w_out[li], pos)
        else:
            x = moba_layer(x, odd_norm_w[li], odd_w_in[li], odd_q_norm[li], odd_k_norm[li],
                           odd_w_out[li], pos)
    return x
```

```cpp
#include <hip/hip_runtime.h>
#include <hip/hip_cooperative_groups.h>
#include <cstdio>
#include <cstdint>
namespace cg = cooperative_groups;

#define LAS __attribute__((address_space(3)))
typedef unsigned short bf16_t;
typedef short bf16x8 __attribute__((ext_vector_type(8)));
typedef short s16x4 __attribute__((ext_vector_type(4)));
typedef float f32x4 __attribute__((ext_vector_type(4)));
typedef float f32x16 __attribute__((ext_vector_type(16)));
typedef unsigned u32x4 __attribute__((ext_vector_type(4)));
typedef unsigned u32x2 __attribute__((ext_vector_type(2)));
#define DI __device__ __forceinline__

constexpr int T = 16384, D = 1024, SEQ = 4096, TS = 8192;
constexpr int N0 = 8192;
constexpr int Z_OFF = 0, XBC_OFF = 1024, Q_OFF = 3072, K_OFF = 4608, V_OFF = 6144, G_OFF = 7680;
constexpr int N1 = 4096;
constexpr int NTHREADS = 512, NWAVES = 8;
constexpr float EPS = 1e-6f, LOG2E = 1.4426950408889634f, LN2 = 0.6931471805599453f;

constexpr size_t WS_W0T = 0;
constexpr size_t WS_WO0T = WS_W0T + (size_t)N0 * D * 2;
constexpr size_t WS_W1T = WS_WO0T + (size_t)1024 * 1536 * 2;
constexpr size_t WS_WO1T = WS_W1T + (size_t)N1 * D * 2;
constexpr size_t WS_XB = WS_WO1T + (size_t)1024 * 1024 * 2;
constexpr size_t WS_PROJ = WS_XB + (size_t)T * D * 2;
constexpr size_t WS_MIXED = WS_PROJ + (size_t)TS * N0 * 2;
constexpr size_t WS_STATES = WS_MIXED + (size_t)T * 1536 * 2;
constexpr size_t WS_RSTD = WS_STATES + (size_t)2 * 16 * 16 * 8192 * 4;
constexpr size_t WS_DTRAW = WS_RSTD + (size_t)T * 4;
constexpr size_t WS_ROPE = WS_DTRAW + (size_t)T * 16 * 4;
constexpr size_t WS_KMEAN = WS_ROPE + (size_t)SEQ * 16 * 4;
constexpr size_t WS_BAR = WS_KMEAN + (size_t)4 * 16 * 16 * 2 * 64 * 4;
constexpr size_t WS_END = WS_BAR + 3200 * 4;
static_assert(WS_END <= (size_t)256 * 1024 * 1024, "workspace");
constexpr size_t DO_CONV = 0;
constexpr size_t DO_OG = DO_CONV + (size_t)TS * 2048 * 2;
constexpr size_t DO_LSE = DO_OG + (size_t)3 * TS * 512 * 2;
constexpr size_t DO_DT = DO_LSE + (size_t)3 * TS * 8 * 4;
constexpr size_t DO_ACS = DO_DT + (size_t)TS * 16 * 4;
static_assert(DO_ACS + (size_t)TS * 16 * 4 <= (size_t)T * D * 4, "d_out scratch");

constexpr int LDS_BYTES = 4 * 256 * 144 + 4096 + 2048;

typedef float f32x2 __attribute__((ext_vector_type(2)));
typedef __bf16 bf16x2_t __attribute__((ext_vector_type(2)));
DI unsigned pk2v(float lo, float hi) { const f32x2 v = {lo, hi}; return __builtin_bit_cast(unsigned, __builtin_convertvector(v, bf16x2_t)); }
DI unsigned pk2(float lo, float hi) { unsigned r; asm("v_cvt_pk_bf16_f32 %0, %1, %2" : "=v"(r) : "v"(lo), "v"(hi)); return r; }
DI float ex2(float x) { return __builtin_amdgcn_exp2f(x); }
DI float bflo(unsigned u) { return __uint_as_float(u << 16); }
DI float bfhi(unsigned u) { return __uint_as_float(u & 0xffff0000u); }
DI float wave_sum(float v) {
#pragma unroll
    for (int o = 1; o < 64; o <<= 1) v += __shfl_xor(v, o);
    return v;
}
DI float silu_f(float v) { return v * __builtin_amdgcn_rcpf(1.f + __expf(-v)); }
DI int crow(int i, int h) { return (i & 3) + 8 * (i >> 2) + 4 * h; }
#define MFMA32(a, b, c) __builtin_amdgcn_mfma_f32_32x32x16_bf16((a), (b), (c), 0, 0, 0)
DI s16x4 tr_read(const unsigned char* p) { return __builtin_amdgcn_ds_read_tr16_b64_v4i16((LAS s16x4*)p); }
DI bf16x8 cat8(s16x4 lo, s16x4 hi) { return __builtin_shufflevector(lo, hi, 0, 1, 2, 3, 4, 5, 6, 7); }
DI bf16x8 pack8(const f32x16& x, int s) {
    u32x4 p; p.x = pk2v(x[8 * s], x[8 * s + 1]); p.y = pk2v(x[8 * s + 2], x[8 * s + 3]); p.z = pk2v(x[8 * s + 4], x[8 * s + 5]); p.w = pk2v(x[8 * s + 6], x[8 * s + 7]);
    return __builtin_bit_cast(bf16x8, p);
}
DI f32x16 zero16() { f32x16 z; for (int i = 0; i < 16; ++i) z[i] = 0.f; return z; }

namespace pg8 {
constexpr int BM = 256, BK = 64, HALF = 128, HTB = HALF * BK * 2, STAGE_BYTES = 8 * HTB, NXCD = 8, WGM = 8;
DI int lds_byte(int r, int c) { const int st = (r >> 4) * 2 + (c >> 5), rr = r & 15, cc = c & 31, ob = rr * 64 + cc * 2; return st * 1024 + (ob ^ (((ob >> 9) & 1) << 5)); }
DI void stage_rc(int b, int& R, int& C) { const int st = b / 1024, sb = b % 1024, swz = sb ^ (((sb >> 9) & 1) << 5); R = (st >> 1) * 16 + swz / 64; C = (st & 1) * 32 + (swz % 64) / 2; }
DI int perm32(int rho) { const int n = rho >> 4, i = rho & 15; return 8 * (i >> 2) + 4 * n + (i & 3); }
struct Unit { int pm, pn; };
struct Gemm { const bf16_t* A; const bf16_t* Bt; int M, N, K, lda, ldb; };
struct StaticOrder {
    int nM, nN, nwg, G, c;
    DI void init(int M, int N, int G_, int c_) { nM = M / BM; nN = N / BM; nwg = nM * nN; G = G_; c = c_; }
    DI bool next(int i, Unit& u) const {
        const long L = (long)i * G + c; if (L >= nwg) return false;
        int wgid = (int)L; { const int q = nwg / NXCD, r = nwg % NXCD, xcd = wgid % NXCD, off = wgid / NXCD; wgid = (xcd < r ? xcd * (q + 1) : r * (q + 1) + (xcd - r) * q) + off; }
        const int nig = WGM * nN, gid = wgid / nig, fm = gid * WGM, gsz = (nM - fm) < WGM ? (nM - fm) : WGM;
        u.pm = fm + ((wgid % nig) % gsz); u.pn = (wgid % nig) / gsz; return true;
    }
};
struct EpiScaleBf16 {
    static constexpr bool PERM = true;
    bf16_t* O; int ldc; const float* rs; const float* psq;
    DI void operator()(const f32x4 (&acc)[2][2][4][2], const Unit& u, int wr, int wc, int fr, int fq) const {
        const int row0 = u.pm * BM + wr * 64 + fr, col0 = u.pn * BM + wc * 32 + 8 * fq;
        float sc[2][4];
        if (rs) {
#pragma unroll
            for (int ai = 0; ai < 2; ++ai)
#pragma unroll
                for (int m = 0; m < 4; ++m) sc[ai][m] = rs[row0 + ai * HALF + m * 16];
        } else {
#pragma unroll
            for (int ai = 0; ai < 2; ++ai) {
                f32x4 pv[4][4];
#pragma unroll
                for (int m = 0; m < 4; ++m) { const f32x4* pp = (const f32x4*)(psq + (size_t)(row0 + ai * HALF + m * 16) * 16);
#pragma unroll
                    for (int j = 0; j < 4; ++j) pv[m][j] = pp[j]; }
#pragma unroll
                for (int m = 0; m < 4; ++m) { const f32x4 a = pv[m][0] + pv[m][1] + pv[m][2] + pv[m][3]; sc[ai][m] = rsqrtf(((a.x + a.y) + (a.z + a.w)) * (1.f / 1024.f) + EPS); }
            }
        }
#pragma unroll
        for (int ai = 0; ai < 2; ++ai)
#pragma unroll
            for (int m = 0; m < 4; ++m) { const int row = row0 + ai * HALF + m * 16; const float s = sc[ai][m];
                bf16_t* rowp = O + (size_t)row * ldc + col0;
#pragma unroll
                for (int bj = 0; bj < 2; ++bj) { const f32x4 v0 = acc[ai][bj][m][0] * s, v1 = acc[ai][bj][m][1] * s;
                    u32x4 w; w.x = pk2(v0[0], v0[1]); w.y = pk2(v0[2], v0[3]); w.z = pk2(v1[0], v1[1]); w.w = pk2(v1[2], v1[3]);
                    *(u32x4*)(rowp + bj * HALF) = w; } }
    }
};
struct EpiResF32X {
    static constexpr bool PERM = false;
    const float* R; float* C; bf16_t* XB; float* psq; int ldc;
    DI void operator()(const f32x4 (&acc)[2][2][4][2], const Unit& u, int wr, int wc, int fr, int fq) const {
        const int row0 = u.pm * BM + wr * 64 + fr, col0 = u.pn * BM + wc * 32 + 4 * fq;
        f32x4 rv[2][2][2][2];
#define EPI_LOAD(buf, q) do { const int ai_ = (q) >> 1, m0_ = ((q) & 1) * 2; _Pragma("unroll") for (int mm = 0; mm < 2; ++mm) _Pragma("unroll") for (int bj = 0; bj < 2; ++bj) _Pragma("unroll") for (int n = 0; n < 2; ++n) \
            rv[buf][mm][bj][n] = *(const f32x4*)(R + (size_t)(row0 + ai_ * HALF + (m0_ + mm) * 16) * ldc + col0 + bj * HALF + n * 16); } while (0)
        EPI_LOAD(0, 0);
#pragma unroll
        for (int q = 0; q < 4; ++q) {
            if (q < 3) { if (q & 1) EPI_LOAD(0, q + 1); else EPI_LOAD(1, q + 1); }
            const int ai = q >> 1, m0 = (q & 1) * 2;
#pragma unroll
            for (int mm = 0; mm < 2; ++mm) { const int m = m0 + mm, row = row0 + ai * HALF + m * 16; const size_t ro = (size_t)row * ldc + col0; float ss = 0.f;
#pragma unroll
                for (int bj = 0; bj < 2; ++bj)
#pragma unroll
                    for (int n = 0; n < 2; ++n) { const size_t idx = ro + bj * HALF + n * 16; const f32x4 v = rv[q & 1][mm][bj][n] + acc[ai][bj][m][n]; *(f32x4*)(C + idx) = v;
                        u32x2 w; w.x = pk2(v.x, v.y); w.y = pk2(v.z, v.w); *(u32x2*)(XB + idx) = w; ss += (v.x * v.x + v.y * v.y) + (v.z * v.z + v.w * v.w); }
                ss += __shfl_xor(ss, 16); ss += __shfl_xor(ss, 32);
                if (fq == 0) psq[(size_t)row * 16 + u.pn * 4 + wc] = ss; }
        }
#undef EPI_LOAD
    }
};
struct EpiResF32 {
    static constexpr bool PERM = false;
    const float* R; float* C; int ldc;
    DI void operator()(const f32x4 (&acc)[2][2][4][2], const Unit& u, int wr, int wc, int fr, int fq) const {
        const int row0 = u.pm * BM + wr * 64 + fr, col0 = u.pn * BM + wc * 32 + 4 * fq;
        f32x4 rv[2][2][2][2];
#define EPI_LOAD(buf, q) do { const int ai_ = (q) >> 1, m0_ = ((q) & 1) * 2; _Pragma("unroll") for (int mm = 0; mm < 2; ++mm) _Pragma("unroll") for (int bj = 0; bj < 2; ++bj) _Pragma("unroll") for (int n = 0; n < 2; ++n) \
            rv[buf][mm][bj][n] = *(const f32x4*)(R + (size_t)(row0 + ai_ * HALF + (m0_ + mm) * 16) * ldc + col0 + bj * HALF + n * 16); } while (0)
        EPI_LOAD(0, 0);
#pragma unroll
        for (int q = 0; q < 4; ++q) {
            if (q < 3) { if (q & 1) EPI_LOAD(0, q + 1); else EPI_LOAD(1, q + 1); }
            const int ai = q >> 1, m0 = (q & 1) * 2;
#pragma unroll
            for (int mm = 0; mm < 2; ++mm)
#pragma unroll
                for (int bj = 0; bj < 2; ++bj)
#pragma unroll
                    for (int n = 0; n < 2; ++n) *(f32x4*)(C + (size_t)(row0 + ai * HALF + (m0 + mm) * 16) * ldc + col0 + bj * HALF + n * 16) = rv[q & 1][mm][bj][n] + acc[ai][bj][m0 + mm][n];
        }
#undef EPI_LOAD
    }
};

template <class Epi, class Sched>
DI void gemm_phase(LAS unsigned char* lds, const Gemm g, const Sched& S, const Epi& E, int tid) {
    const int wid = __builtin_amdgcn_readfirstlane(tid >> 6), lane = tid & 63, wr = wid >> 2, wc = wid & 3, fr = lane & 15, fq = lane >> 4;
    const int K = g.K, nt = K / BK;
    unsigned voffA[2], voffB[2];
#pragma unroll
    for (int i = 0; i < 2; ++i) { int R, C; stage_rc(tid * 16 + i * 8192, R, C); const int Rb = Epi::PERM ? ((R & ~31) + perm32(R & 31)) : R;
        voffA[i] = (unsigned)(R * g.lda + C) * 2u; voffB[i] = (unsigned)(Rb * g.ldb + C) * 2u; }
    const size_t kstep = (size_t)(BK * 2);
    const size_t hstepA = (size_t)HALF * g.lda * 2, hstepB = (size_t)HALF * g.ldb * 2;
    const size_t tstepA = 2 * hstepA, tstepB = 2 * hstepB;
    const unsigned ldsw = (unsigned)wid * 1024u;
    const int aoff = lds_byte(wr * 64 + fr, fq * 8), boff = lds_byte(wc * 32 + fr, fq * 8);
#define PG8_SA(b, h) (((b) * 2 + (h)) * HTB)
#define PG8_SB(b, h) ((4 + (b) * 2 + (h)) * HTB)
#define PG8_STAGE(bufoff, gbase, voff) do { _Pragma("unroll") for (int _i = 0; _i < 2; ++_i) \
        __builtin_amdgcn_global_load_lds((const unsigned*)((const char*)(gbase) + (voff)[_i]), (LAS unsigned*)(lds + (bufoff) + ldsw + _i * 8192), 16, 0, 0); } while (0)
#define PG8_LDA(dst, b, h) do { _Pragma("unroll") for (int m = 0; m < 4; ++m) _Pragma("unroll") for (int k = 0; k < 2; ++k) dst[m][k] = *(const LAS bf16x8*)(lds + PG8_SA(b, h) + aoff + m * 2048 + k * 1024); } while (0)
#define PG8_LDB(dst, b, h) do { _Pragma("unroll") for (int n = 0; n < 2; ++n) _Pragma("unroll") for (int k = 0; k < 2; ++k) dst[n][k] = *(const LAS bf16x8*)(lds + PG8_SB(b, h) + boff + n * 2048 + k * 1024); } while (0)
#define PG8_MMA(ai, bj, At, Bt) do { __builtin_amdgcn_s_setprio(1); _Pragma("unroll") for (int m = 0; m < 4; ++m) _Pragma("unroll") for (int n = 0; n < 2; ++n) _Pragma("unroll") for (int k = 0; k < 2; ++k) \
        acc[ai][bj][m][n] = __builtin_amdgcn_mfma_f32_16x16x32_bf16(Bt[n][k], At[m][k], acc[ai][bj][m][n], 0, 0, 0); __builtin_amdgcn_s_setprio(0); } while (0)
#define PG8_WAIT_V(n) asm volatile("s_waitcnt vmcnt(" #n ")" ::: "memory")
#define PG8_WAIT_L(n) asm volatile("s_waitcnt lgkmcnt(" #n ")" ::: "memory")
#define PG8_BAR __builtin_amdgcn_s_barrier()
#define PG8_SCHED __builtin_amdgcn_sched_barrier(0)
    Unit cur, nxt; int ui = 0;
    if (!S.next(0, cur)) return;
    f32x4 acc[2][2][4][2];
#pragma unroll
    for (int a = 0; a < 2; ++a)
#pragma unroll
        for (int b = 0; b < 2; ++b)
#pragma unroll
            for (int m = 0; m < 4; ++m)
#pragma unroll
                for (int n = 0; n < 2; ++n) acc[a][b][m][n] = (f32x4){0.f, 0.f, 0.f, 0.f};
    bf16x8 At[4][2], B0[2][2], B1[2][2];
    const char* cA = (const char*)g.A + (size_t)cur.pm * tstepA; const char* cB = (const char*)g.Bt + (size_t)cur.pn * tstepB;
    PG8_STAGE(PG8_SB(0, 0), cB, voffB); PG8_STAGE(PG8_SA(0, 0), cA, voffA); PG8_STAGE(PG8_SB(0, 1), cB + hstepB, voffB); PG8_STAGE(PG8_SA(0, 1), cA + hstepA, voffA);
    if (wr == 1) PG8_BAR;
    PG8_WAIT_V(4); PG8_BAR;
    PG8_STAGE(PG8_SB(1, 0), cB + kstep, voffB); PG8_STAGE(PG8_SA(1, 0), cA + kstep, voffA); PG8_STAGE(PG8_SB(1, 1), cB + hstepB + kstep, voffB);
    PG8_WAIT_V(6); PG8_BAR;
    for (;;) {
        const bool has_next = S.next(ui + 1, nxt);
        const char* nA = has_next ? (const char*)g.A + (size_t)nxt.pm * tstepA : cA; const char* nB = has_next ? (const char*)g.Bt + (size_t)nxt.pn * tstepB : cB;
        for (int t = 0; t < nt; t += 2) {
            const bool last = (t == nt - 2);
            const char* a1 = cA + (size_t)(t + 1) * kstep;
            const char* a2 = last ? nA : cA + (size_t)(t + 2) * kstep; const char* b2 = last ? nB : cB + (size_t)(t + 2) * kstep;
            const char* a3 = a2 + kstep; const char* b3 = b2 + kstep;
            PG8_LDB(B0, 0, 0); PG8_SCHED; PG8_LDA(At, 0, 0); PG8_STAGE(PG8_SA(1, 1), a1 + hstepA, voffA);
            PG8_WAIT_L(8); PG8_BAR; PG8_WAIT_L(0); PG8_MMA(0, 0, At, B0); PG8_BAR; PG8_SCHED;
            PG8_LDB(B1, 0, 1); PG8_STAGE(PG8_SB(0, 0), b2, voffB);
            PG8_BAR; PG8_WAIT_L(0); PG8_MMA(0, 1, At, B1); PG8_BAR;
            PG8_LDA(At, 0, 1); PG8_STAGE(PG8_SA(0, 0), a2, voffA);
            PG8_BAR; PG8_WAIT_L(0); PG8_MMA(1, 0, At, B0); PG8_BAR; PG8_SCHED;
            PG8_STAGE(PG8_SB(0, 1), b2 + hstepB, voffB);
            PG8_WAIT_V(6); PG8_BAR; PG8_MMA(1, 1, At, B1); PG8_BAR;
            PG8_LDB(B0, 1, 0); PG8_SCHED; PG8_LDA(At, 1, 0); PG8_STAGE(PG8_SA(0, 1), a2 + hstepA, voffA);
            PG8_WAIT_L(8); PG8_BAR; PG8_WAIT_L(0); PG8_MMA(0, 0, At, B0); PG8_BAR; PG8_SCHED;
            PG8_LDB(B1, 1, 1); PG8_STAGE(PG8_SB(1, 0), b3, voffB);
            PG8_BAR; PG8_WAIT_L(0); PG8_MMA(0, 1, At, B1); PG8_BAR;
            PG8_LDA(At, 1, 1); PG8_STAGE(PG8_SA(1, 0), a3, voffA);
            PG8_BAR; PG8_WAIT_L(0); PG8_MMA(1, 0, At, B0); PG8_BAR; PG8_SCHED;
            PG8_STAGE(PG8_SB(1, 1), b3 + hstepB, voffB);
            PG8_WAIT_V(6); PG8_BAR; PG8_MMA(1, 1, At, B1); PG8_BAR;
        }
        E(acc, cur, wr, wc, fr, fq);
        if (!has_next) break;
#pragma unroll
        for (int a = 0; a < 2; ++a)
#pragma unroll
            for (int b = 0; b < 2; ++b)
#pragma unroll
                for (int m = 0; m < 4; ++m)
#pragma unroll
                    for (int n = 0; n < 2; ++n) acc[a][b][m][n] = (f32x4){0.f, 0.f, 0.f, 0.f};
        cur = nxt; cA = nA; cB = nB; ++ui;
    }
    PG8_WAIT_V(0);
    if (wr == 0) PG8_BAR;
    PG8_BAR;
#undef PG8_SA
#undef PG8_SB
#undef PG8_STAGE
#undef PG8_LDA
#undef PG8_LDB
#undef PG8_MMA
#undef PG8_WAIT_V
#undef PG8_WAIT_L
#undef PG8_BAR
#undef PG8_SCHED
}
}


struct Params {
    const float *x, *e_norm_w, *e_w_in, *e_conv_w, *e_conv_b, *e_dt_bias, *e_a_log, *e_d_skip, *e_ssd_norm_w, *e_q_norm, *e_k_norm, *e_w_out;
    const float *o_norm_w, *o_w_in, *o_q_norm, *o_k_norm, *o_w_out;
    float* out; unsigned char* ws;
};
#define LDS_WAIT() asm volatile("s_waitcnt lgkmcnt(0)" ::: "memory")

DI void transpose_item(const float* W, int Ns, int K, bf16_t* WT, int n0, int sc0, int k0, const float* scale, float* scr, int lane) {
    float wv[32];
#pragma unroll
    for (int i = 0; i < 32; ++i) { const int kk = 2 * i + (lane >> 5); wv[i] = W[(size_t)(k0 + kk) * Ns + sc0 + (lane & 31)]; }
#pragma unroll
    for (int i = 0; i < 32; ++i) { const int kk = 2 * i + (lane >> 5); const float sc = scale ? scale[k0 + kk] : 1.f; scr[kk * 33 + (lane & 31)] = wv[i] * sc; }
    LDS_WAIT();
    const int c = lane & 7;
#pragma unroll
    for (int j = 0; j < 4; ++j) { const int n = (lane >> 3) + 8 * j; const float* s = scr + (8 * c) * 33 + n;
        u32x4 o; o.x = pk2(s[0 * 33], s[1 * 33]); o.y = pk2(s[2 * 33], s[3 * 33]); o.z = pk2(s[4 * 33], s[5 * 33]); o.w = pk2(s[6 * 33], s[7 * 33]);
        *(u32x4*)(WT + (size_t)(n0 + n) * K + k0 + 8 * c) = o; }
    LDS_WAIT();
}

template <bool WITH_DT>
DI void rows_phase(const float* src, bf16_t* xb, float* rstd_out, float* dtraw, const f32x4* wl, int gw, int NGW, int lane) {
    for (int row = gw; row < T; row += NGW) {
        const f32x4* xr = (const f32x4*)(src + (size_t)row * D) + lane;
        f32x4 v[4]; float ss = 0.f;
#pragma unroll
        for (int j = 0; j < 4; ++j) { v[j] = xr[64 * j]; ss += (v[j].x * v[j].x + v[j].y * v[j].y) + (v[j].z * v[j].z + v[j].w * v[j].w); }
        const float rstd = rsqrtf(wave_sum(ss) * (1.f / D) + EPS);
        u32x2* o8 = (u32x2*)(xb + (size_t)row * D) + lane;
#pragma unroll
        for (int j = 0; j < 4; ++j) { u32x2 w; w.x = pk2(v[j].x, v[j].y); w.y = pk2(v[j].z, v[j].w); o8[64 * j] = w; }
        if (lane == 0) rstd_out[row] = rstd;
        if (WITH_DT) {
            f32x4 acc[4];
#pragma unroll
            for (int c = 0; c < 4; ++c) acc[c] = (f32x4){0.f, 0.f, 0.f, 0.f};
#pragma unroll
            for (int j = 0; j < 4; ++j)
#pragma unroll
                for (int t = 0; t < 4; ++t) { const float xv = v[j][t];
#pragma unroll
                    for (int c = 0; c < 4; ++c) acc[c] += wl[((j * 4 + t) * 4 + c) * 64 + lane] * xv; }
            float a[16];
#pragma unroll
            for (int c = 0; c < 4; ++c)
#pragma unroll
                for (int t = 0; t < 4; ++t) a[c * 4 + t] = acc[c][t];
#pragma unroll
            for (int i = 0; i < 8; ++i) { const bool up = (lane & 32) != 0; const float keep = up ? a[i + 8] : a[i], send = up ? a[i] : a[i + 8]; a[i] = keep + __shfl_xor(send, 32); }
#pragma unroll
            for (int i = 0; i < 4; ++i) { const bool up = (lane & 16) != 0; const float keep = up ? a[i + 4] : a[i], send = up ? a[i] : a[i + 4]; a[i] = keep + __shfl_xor(send, 16); }
#pragma unroll
            for (int i = 0; i < 2; ++i) { const bool up = (lane & 8) != 0; const float keep = up ? a[i + 2] : a[i], send = up ? a[i] : a[i + 2]; a[i] = keep + __shfl_xor(send, 8); }
            { const bool up = (lane & 4) != 0; const float keep = up ? a[1] : a[0], send = up ? a[0] : a[1]; a[0] = keep + __shfl_xor(send, 4); }
            a[0] += __shfl_xor(a[0], 2); a[0] += __shfl_xor(a[0], 1);
            if ((lane & 3) == 0) dtraw[(size_t)row * 16 + (lane >> 2)] = a[0] * rstd;
        }
    }
}

DI void qk_norm_rope_item(bf16_t* base, int ld, int row0, int nsub, int col, const float* w, float qscale, const float* rope, float* kmean_out, int lane) {
    const int c = lane & 7, rs = lane >> 3;
    float wv[8], msum[8];
#pragma unroll
    for (int j = 0; j < 8; ++j) { wv[j] = w[8 * c + j] * qscale; msum[j] = 0.f; }
    for (int sub = 0; sub < nsub; ++sub) {
        u32x4 raw[4]; f32x4 rpv[4][4];
#pragma unroll
        for (int ps = 0; ps < 4; ++ps) { raw[ps] = *(const u32x4*)(base + (size_t)(row0 + sub * 32 + ps * 8 + rs) * ld + col + 8 * c);
            const f32x4* rp = (const f32x4*)(rope + ((row0 + sub * 32 + ps * 8 + rs) & (SEQ - 1)) * 16);
#pragma unroll
            for (int j = 0; j < 4; ++j) rpv[ps][j] = (c < 2) ? rp[j] : (f32x4){0.f, 0.f, 0.f, 0.f}; }
#pragma unroll
        for (int ps = 0; ps < 4; ++ps) {
            const int row = row0 + sub * 32 + ps * 8 + rs, pos = row & (SEQ - 1);
            float v[8] = {bflo(raw[ps].x), bfhi(raw[ps].x), bflo(raw[ps].y), bfhi(raw[ps].y), bflo(raw[ps].z), bfhi(raw[ps].z), bflo(raw[ps].w), bfhi(raw[ps].w)};
            float ss = 0.f;
#pragma unroll
            for (int j = 0; j < 8; ++j) ss += v[j] * v[j];
            ss += __shfl_xor(ss, 1); ss += __shfl_xor(ss, 2); ss += __shfl_xor(ss, 4);
            const float r = rsqrtf(ss * (1.f / 64.f) + EPS);
#pragma unroll
            for (int j = 0; j < 8; ++j) v[j] *= r * wv[j];
            float o[8];
#pragma unroll
            for (int j = 0; j < 8; ++j) o[j] = __shfl_xor(v[j], 1);
            if (c < 2) {
                const f32x4 c0 = rpv[ps][0], c1 = rpv[ps][1], s0 = rpv[ps][2], s1 = rpv[ps][3];
                const float cs[8] = {c0.x, c0.y, c0.z, c0.w, c1.x, c1.y, c1.z, c1.w}, sn[8] = {s0.x, s0.y, s0.z, s0.w, s1.x, s1.y, s1.z, s1.w};
#pragma unroll
                for (int j = 0; j < 8; ++j) v[j] = (c == 0) ? (v[j] * cs[j] - o[j] * sn[j]) : (v[j] * cs[j] + o[j] * sn[j]);
            }
            u32x4 w4; w4.x = pk2(v[0], v[1]); w4.y = pk2(v[2], v[3]); w4.z = pk2(v[4], v[5]); w4.w = pk2(v[6], v[7]);
            *(u32x4*)(base + (size_t)row * ld + col + 8 * c) = w4;
#pragma unroll
            for (int j = 0; j < 8; ++j) msum[j] += v[j];
        }
    }
    if (kmean_out) {
#pragma unroll
        for (int j = 0; j < 8; ++j) { float s = msum[j]; s += __shfl_xor(s, 8); s += __shfl_xor(s, 16); s += __shfl_xor(s, 32); if (rs == 0) kmean_out[8 * c + j] = s; }
    }
}

DI void conv_item(const bf16_t* proj, bf16_t* conv, const float* cw, const float* cb, int row0, int ch0, int lane) {
    const int ch = ch0 + lane * 8;
    u32x4 rr[19];
    const bool head = (row0 & (SEQ - 1)) == 0;
#pragma unroll
    for (int t = 0; t < 19; ++t) { if (t >= 3 || !head) rr[t] = *(const u32x4*)(proj + (size_t)(row0 + t - 3) * N0 + XBC_OFF + ch); else rr[t] = (u32x4){0u, 0u, 0u, 0u}; }
    float w0[8], w1[8], w2[8], w3[8], b[8];
#pragma unroll
    for (int j = 0; j < 8; ++j) { const f32x4 ww = *(const f32x4*)(cw + (size_t)(ch + j) * 4); w0[j] = ww.x; w1[j] = ww.y; w2[j] = ww.z; w3[j] = ww.w; b[j] = cb[ch + j]; }
#pragma unroll
    for (int t = 0; t < 16; ++t) {
        const u32x4 a = rr[t], bq = rr[t + 1], c = rr[t + 2], d = rr[t + 3];
        const float x0[8] = {bflo(a.x), bfhi(a.x), bflo(a.y), bfhi(a.y), bflo(a.z), bfhi(a.z), bflo(a.w), bfhi(a.w)};
        const float x1[8] = {bflo(bq.x), bfhi(bq.x), bflo(bq.y), bfhi(bq.y), bflo(bq.z), bfhi(bq.z), bflo(bq.w), bfhi(bq.w)};
        const float x2[8] = {bflo(c.x), bfhi(c.x), bflo(c.y), bfhi(c.y), bflo(c.z), bfhi(c.z), bflo(c.w), bfhi(c.w)};
        const float x3[8] = {bflo(d.x), bfhi(d.x), bflo(d.y), bfhi(d.y), bflo(d.z), bfhi(d.z), bflo(d.w), bfhi(d.w)};
        float y[8];
#pragma unroll
        for (int j = 0; j < 8; ++j) y[j] = silu_f(b[j] + w0[j] * x0[j] + w1[j] * x1[j] + w2[j] * x2[j] + w3[j] * x3[j]);
        u32x4 o; o.x = pk2(y[0], y[1]); o.y = pk2(y[2], y[3]); o.z = pk2(y[4], y[5]); o.w = pk2(y[6], y[7]);
        *(u32x4*)(conv + (size_t)(row0 + t) * 2048 + ch) = o;
    }
}

DI void dt_item(const float* dtraw, float* dt_out, float* acs_out, const float* dt_bias, const float* a_log, int item, int lane) {
    const int h = item & 15, row0 = (item >> 4) * 256;
    const float bias = dt_bias[h], A = -expf(a_log[h]);
    float d[4], a[4];
#pragma unroll
    for (int t = 0; t < 4; ++t) d[t] = dtraw[(size_t)(row0 + 4 * lane + t) * 16 + h];
#pragma unroll
    for (int t = 0; t < 4; ++t) { const float v = d[t] + bias; d[t] = fmaxf(v, 0.f) + log1pf(expf(-fabsf(v))); a[t] = d[t] * A; }
    a[1] += a[0]; a[2] += a[1]; a[3] += a[2];
    float tot = a[3];
#pragma unroll
    for (int o = 1; o < 64; o <<= 1) { const float n = __shfl_up(tot, o); if (lane >= o) tot += n; }
    const float excl = tot - a[3];
#pragma unroll
    for (int t = 0; t < 4; ++t) { const size_t idx = (size_t)(row0 + 4 * lane + t) * 16 + h; dt_out[idx] = d[t]; acs_out[idx] = a[t] + excl; }
}

DI void softmax_fs2(f32x16& sa, f32x16& sb, float& l, f32x16& o0, f32x16& o1, const unsigned char* Vs, int vrow0, int lane, float shl) {
    const int hh = lane >> 5, q = (lane & 15) >> 2, p = lane & 3, blk = (lane >> 4) & 1;
    float ls0 = 0.f, ls1 = 0.f;
#pragma unroll
    for (int i = 0; i < 16; ++i) { const float pa = ex2(__builtin_fmaf(sa[i], LOG2E, -shl)), pb = ex2(__builtin_fmaf(sb[i], LOG2E, -shl)); sa[i] = pa; sb[i] = pb; ls0 += pa; ls1 += pb; }
    l += ls0 + ls1;
    const unsigned char* vb = Vs + (size_t)(vrow0 + 4 * hh + q) * 144 + 32 * blk + 8 * p;
#pragma unroll
    for (int sp = 0; sp < 2; ++sp) {
        const bf16x8 pfa = pack8(sa, sp), pfb = pack8(sb, sp);
        const unsigned char* va = vb + (size_t)(16 * sp) * 144; const unsigned char* vc = va + 32 * 144;
        o0 = MFMA32(cat8(tr_read(va), tr_read(va + 8 * 144)), pfa, o0);
        o1 = MFMA32(cat8(tr_read(va + 64), tr_read(va + 8 * 144 + 64)), pfa, o1);
        o0 = MFMA32(cat8(tr_read(vc), tr_read(vc + 8 * 144)), pfb, o0);
        o1 = MFMA32(cat8(tr_read(vc + 64), tr_read(vc + 8 * 144 + 64)), pfb, o1);
    }
}
DI void softmax_fs1(f32x16& s, float& l, f32x16& o0, f32x16& o1, const unsigned char* Vs, int vrow0, int lane, float shl) {
    const int hh = lane >> 5, q = (lane & 15) >> 2, p = lane & 3, blk = (lane >> 4) & 1;
    float ls = 0.f;
#pragma unroll
    for (int i = 0; i < 16; ++i) { const float pe = ex2(__builtin_fmaf(s[i], LOG2E, -shl)); s[i] = pe; ls += pe; }
    l += ls;
#pragma unroll
    for (int sp = 0; sp < 2; ++sp) {
        const bf16x8 pf = pack8(s, sp);
        const unsigned char* vb = Vs + (size_t)(vrow0 + 16 * sp + 4 * hh + q) * 144 + 32 * blk + 8 * p;
        o0 = MFMA32(cat8(tr_read(vb), tr_read(vb + 8 * 144)), pf, o0);
        o1 = MFMA32(cat8(tr_read(vb + 64), tr_read(vb + 8 * 144 + 64)), pf, o1);
    }
}
DI float score_bound(const float* qnw, const float* knw, int lane) {
    float a = fabsf(qnw[lane]), b = fabsf(knw[lane]);
#pragma unroll
    for (int o = 1; o < 64; o <<= 1) { a = fmaxf(a, __shfl_xor(a, o)); b = fmaxf(b, __shfl_xor(b, o)); }
    return 8.f * a * b;
}
DI void softmax_exp2t(const f32x16& sa, const f32x16& sb, float& l, bf16x8 (&pf)[4], float shl) {
    f32x16 pa, pb; float ls0 = 0.f, ls1 = 0.f;
#pragma unroll
    for (int i = 0; i < 16; ++i) { pa[i] = ex2(__builtin_fmaf(sa[i], LOG2E, -shl)); pb[i] = ex2(__builtin_fmaf(sb[i], LOG2E, -shl)); ls0 += pa[i]; ls1 += pb[i]; }
    l += ls0 + ls1;
    pf[0] = pack8(pa, 0); pf[1] = pack8(pa, 1); pf[2] = pack8(pb, 0); pf[3] = pack8(pb, 1);
}
DI void pv_mfma2t(const bf16x8 (&pf)[4], f32x16& o0, f32x16& o1, const unsigned char* Vs, int vrow0, int lane) {
    const int hh = lane >> 5, q = (lane & 15) >> 2, p = lane & 3, blk = (lane >> 4) & 1;
    const unsigned char* vb = Vs + (size_t)(vrow0 + 4 * hh + q) * 144 + 32 * blk + 8 * p;
#pragma unroll
    for (int sp = 0; sp < 2; ++sp) {
        const unsigned char* va = vb + (size_t)(16 * sp) * 144; const unsigned char* vc = va + 32 * 144;
        o0 = MFMA32(cat8(tr_read(va), tr_read(va + 8 * 144)), pf[sp], o0);
        o1 = MFMA32(cat8(tr_read(va + 64), tr_read(va + 8 * 144 + 64)), pf[sp], o1);
        o0 = MFMA32(cat8(tr_read(vc), tr_read(vc + 8 * 144)), pf[2 + sp], o0);
        o1 = MFMA32(cat8(tr_read(vc + 64), tr_read(vc + 8 * 144 + 64)), pf[2 + sp], o1);
    }
}
#define SCHED_MIX(n) do { _Pragma("unroll") for (int i_ = 0; i_ < (n); ++i_) { __builtin_amdgcn_sched_group_barrier(0x008, 1, 0); __builtin_amdgcn_sched_group_barrier(0x100, 2, 0); __builtin_amdgcn_sched_group_barrier(0x002, 6, 0); } } while (0)
DI f32x16 qk_tile(const unsigned char* Ks, int kt, const bf16x8 (&qf)[4], int lane) {
    const int r = lane & 31, hh = lane >> 5;
    const unsigned char* kp = Ks + (size_t)(kt + r) * 144 + 16 * hh;
    f32x16 s = zero16();
#pragma unroll
    for (int kk = 0; kk < 4; ++kk) s = MFMA32(*(const bf16x8*)(kp + 32 * kk), qf[kk], s);
    return s;
}
DI void mask_le(f32x16& s, int lane) { const int r = lane & 31, hh = lane >> 5;
#pragma unroll
    for (int i = 0; i < 16; ++i) s[i] = (crow(i, hh) <= r) ? s[i] : -1e30f; }
DI void mask_ge(f32x16& s, int lane) { const int r = lane & 31, hh = lane >> 5;
#pragma unroll
    for (int i = 0; i < 16; ++i) s[i] = (crow(i, hh) >= r) ? s[i] : -1e30f; }

DI void dil_attn_item(unsigned char* lds, const bf16_t* proj, bf16_t* og, float* lse, const float* qnw, const float* knw, const float* rope, int item, int tid, int wave, int lane) {
    const int gi = item >> 8, within = item & 255, dsh = 2 * gi, dil = 1 << dsh;
    const int tps = 16 >> dsh, seq = within / tps, tile = within % tps;
    const int res = seq & (dil - 1), bs = seq >> dsh, slot = bs & 7, bl = bs >> 3;
    const int u0 = tile * 256, head = gi * 8 + slot, rowbase = bl * SEQ + res;
    const int r = lane & 31, hh = lane >> 5;
    unsigned char* Ks = lds; unsigned char* Vs = lds + 384 * 144;
    {
        const int ck = tid & 7;
        float wk[8];
#pragma unroll
        for (int j = 0; j < 8; ++j) wk[j] = knw[8 * ck + j];
        {
        u32x4 kr[6], vr[6]; f32x4 rpv[6][4];
#pragma unroll
        for (int i = 0; i < 6; ++i) { const int ki = (tid >> 3) + 64 * i, u = u0 - 128 + ki;
            if (u >= 0) { const bf16_t* src = proj + (size_t)(rowbase + u * dil) * N0 + head * 64 + ck * 8; kr[i] = *(const u32x4*)(src + K_OFF); vr[i] = *(const u32x4*)(src + V_OFF);
                const f32x4* rp = (const f32x4*)(rope + (u * dil + res) * 16);
#pragma unroll
                for (int j = 0; j < 4; ++j) rpv[i][j] = rp[j]; } }
#pragma unroll
        for (int i = 0; i < 6; ++i) { const int ki = (tid >> 3) + 64 * i, u = u0 - 128 + ki;
            if (u >= 0) {
                float v[8] = {bflo(kr[i].x), bfhi(kr[i].x), bflo(kr[i].y), bfhi(kr[i].y), bflo(kr[i].z), bfhi(kr[i].z), bflo(kr[i].w), bfhi(kr[i].w)};
                float ss = 0.f;
#pragma unroll
                for (int j = 0; j < 8; ++j) ss += v[j] * v[j];
                ss += __shfl_xor(ss, 1); ss += __shfl_xor(ss, 2); ss += __shfl_xor(ss, 4);
                const float rn = rsqrtf(ss * (1.f / 64.f) + EPS);
#pragma unroll
                for (int j = 0; j < 8; ++j) v[j] *= rn * wk[j];
                float o[8];
#pragma unroll
                for (int j = 0; j < 8; ++j) o[j] = __shfl_xor(v[j], 1);
                if (ck < 2) {
                    const f32x4 c0 = rpv[i][0], c1 = rpv[i][1], s0 = rpv[i][2], s1 = rpv[i][3];
                    const float cs[8] = {c0.x, c0.y, c0.z, c0.w, c1.x, c1.y, c1.z, c1.w}, sn[8] = {s0.x, s0.y, s0.z, s0.w, s1.x, s1.y, s1.z, s1.w};
#pragma unroll
                    for (int j = 0; j < 8; ++j) v[j] = (ck == 0) ? (v[j] * cs[j] - o[j] * sn[j]) : (v[j] * cs[j] + o[j] * sn[j]);
                }
                u32x4 w4; w4.x = pk2(v[0], v[1]); w4.y = pk2(v[2], v[3]); w4.z = pk2(v[4], v[5]); w4.w = pk2(v[6], v[7]);
                *(u32x4*)(Ks + ki * 144 + ck * 16) = w4; *(u32x4*)(Vs + ki * 144 + ck * 16) = vr[i];
            } }
        }
    }
    const int upos = u0 + 32 * wave + r, qrow = rowbase + upos * dil;
    bf16x8 qf[4];
    {
        u32x4 qr[4]; f32x4 qw0[4], qw1[4];
#pragma unroll
        for (int kk = 0; kk < 4; ++kk) { qr[kk] = *(const u32x4*)(proj + (size_t)qrow * N0 + Q_OFF + head * 64 + 16 * kk + 8 * hh);
            qw0[kk] = *(const f32x4*)(qnw + 16 * kk + 8 * hh); qw1[kk] = *(const f32x4*)(qnw + 16 * kk + 8 * hh + 4); }
        float qv[4][8]; float ss = 0.f;
#pragma unroll
        for (int kk = 0; kk < 4; ++kk) { qv[kk][0] = bflo(qr[kk].x); qv[kk][1] = bfhi(qr[kk].x); qv[kk][2] = bflo(qr[kk].y); qv[kk][3] = bfhi(qr[kk].y); qv[kk][4] = bflo(qr[kk].z); qv[kk][5] = bfhi(qr[kk].z); qv[kk][6] = bflo(qr[kk].w); qv[kk][7] = bfhi(qr[kk].w);
#pragma unroll
            for (int j = 0; j < 8; ++j) ss += qv[kk][j] * qv[kk][j]; }
        ss += __shfl_xor(ss, 32);
        const float rn = rsqrtf(ss * (1.f / 64.f) + EPS) * 0.125f;
#pragma unroll
        for (int kk = 0; kk < 4; ++kk) { const f32x4 w0 = qw0[kk], w1 = qw1[kk];
            qv[kk][0] *= rn * w0.x; qv[kk][1] *= rn * w0.y; qv[kk][2] *= rn * w0.z; qv[kk][3] *= rn * w0.w; qv[kk][4] *= rn * w1.x; qv[kk][5] *= rn * w1.y; qv[kk][6] *= rn * w1.z; qv[kk][7] *= rn * w1.w; }
        {
            const f32x4* rp = (const f32x4*)(rope + (upos * dil + res) * 16);
            const f32x4 c0 = rp[0], c1 = rp[1], s0 = rp[2], s1 = rp[3];
            const float cs[8] = {c0.x, c0.y, c0.z, c0.w, c1.x, c1.y, c1.z, c1.w}, sn[8] = {s0.x, s0.y, s0.z, s0.w, s1.x, s1.y, s1.z, s1.w};
#pragma unroll
            for (int j = 0; j < 8; ++j) { const float o = __shfl_xor(qv[0][j], 32); qv[0][j] = (hh == 0) ? (qv[0][j] * cs[j] - o * sn[j]) : (qv[0][j] * cs[j] + o * sn[j]); }
        }
#pragma unroll
        for (int kk = 0; kk < 4; ++kk) { u32x4 w4; w4.x = pk2(qv[kk][0], qv[kk][1]); w4.y = pk2(qv[kk][2], qv[kk][3]); w4.z = pk2(qv[kk][4], qv[kk][5]); w4.w = pk2(qv[kk][6], qv[kk][7]); qf[kk] = __builtin_bit_cast(bf16x8, w4); }
    }
    __syncthreads();
    const float smax = score_bound(qnw, knw, lane), shl = smax * LOG2E;
    float l = 0.f; f32x16 o0 = zero16(), o1 = zero16();
    const int tb = (u0 == 0) ? (wave < 4 ? 4 - wave : 0) : 0;
    for (int t = tb; t < 5;) {
        const int kt = 32 * (wave + t);
        if (t + 1 < 5) {
            f32x16 sa = qk_tile(Ks, kt, qf, lane), sb = qk_tile(Ks, kt + 32, qf, lane);
            if (t == 0) mask_ge(sa, lane);
            if (t + 1 == 4) mask_le(sb, lane);
            softmax_fs2(sa, sb, l, o0, o1, Vs, kt, lane, shl);
            t += 2;
        } else {
            f32x16 s = qk_tile(Ks, kt, qf, lane);
            mask_le(s, lane);
            softmax_fs1(s, l, o0, o1, Vs, kt, lane, shl);
            t += 1;
        }
    }
    l += __shfl_xor(l, 32);
    const float inv = 1.f / l;
    bf16_t* orow = og + ((size_t)gi * TS + qrow) * 512 + slot * 64;
#pragma unroll
    for (int ig = 0; ig < 4; ++ig) {
        u32x2 w; w.x = pk2(o0[4 * ig] * inv, o0[4 * ig + 1] * inv); w.y = pk2(o0[4 * ig + 2] * inv, o0[4 * ig + 3] * inv); *(u32x2*)(orow + 8 * ig + 4 * hh) = w;
        w.x = pk2(o1[4 * ig] * inv, o1[4 * ig + 1] * inv); w.y = pk2(o1[4 * ig + 2] * inv, o1[4 * ig + 3] * inv); *(u32x2*)(orow + 32 + 8 * ig + 4 * hh) = w;
    }
    if (hh == 0) lse[((size_t)gi * TS + qrow) * 8 + slot] = smax + logf(l);
    __syncthreads();
}

DI void ssd_intra_item(unsigned char* lds, bf16_t* conv, const float* dt, const float* acs, float* states, const float* d_skip, int item, int tid, int wave, int lane) {
    const int h = item & 15, bc = item >> 4, g = h >> 2, row0 = bc * 256;
    const int r = lane & 31, hh = lane >> 5, q = (lane & 15) >> 2, p = lane & 3, blk = (lane >> 4) & 1;
    unsigned char* Bs = lds; unsigned char* Xs = lds + 256 * 272; float* acs_s = (float*)(lds + 256 * 272 + 256 * 144);
    if (tid < 256) acs_s[tid] = acs[(size_t)(row0 + tid) * 16 + h];
#pragma unroll
    for (int i = 0; i < 8; ++i) { const int e = tid + 512 * i, row = e >> 4, ck = e & 15;
        *(u32x4*)(Bs + row * 272 + ck * 16) = *(const u32x4*)(conv + (size_t)(row0 + row) * 2048 + 1024 + g * 128 + ck * 8); }
#pragma unroll
    for (int i = 0; i < 4; ++i) { const int e = tid + 512 * i, row = e >> 3, ck = e & 7;
        const u32x4 raw = *(const u32x4*)(conv + (size_t)(row0 + row) * 2048 + h * 64 + ck * 8); const float dv = dt[(size_t)(row0 + row) * 16 + h];
        u32x4 w; w.x = pk2(bflo(raw.x) * dv, bfhi(raw.x) * dv); w.y = pk2(bflo(raw.y) * dv, bfhi(raw.y) * dv); w.z = pk2(bflo(raw.z) * dv, bfhi(raw.z) * dv); w.w = pk2(bflo(raw.w) * dv, bfhi(raw.w) * dv);
        *(u32x4*)(Xs + row * 144 + ck * 16) = w; }
    const int l0 = 32 * wave;
    bf16x8 cf[8];
#pragma unroll
    for (int kk = 0; kk < 8; ++kk) cf[kk] = *(const bf16x8*)(conv + (size_t)(row0 + l0 + r) * 2048 + 1536 + g * 128 + 16 * kk + 8 * hh);
    __syncthreads();
    const float acl = acs_s[l0 + r] * LOG2E;
    f32x16 y0 = zero16(), y1 = zero16();
    for (int st = 0; st <= wave; ++st) {
        const int s0 = 32 * st;
        f32x16 x = zero16();
#pragma unroll
        for (int kk = 0; kk < 8; ++kk) { const bf16x8 a = *(const bf16x8*)(Bs + (s0 + r) * 272 + (16 * kk + 8 * hh) * 2); x = MFMA32(a, cf[kk], x); }
        const bool diag = (st == wave);
#pragma unroll
        for (int g4 = 0; g4 < 4; ++g4) { const f32x4 as4 = *(const f32x4*)(acs_s + s0 + 8 * g4 + 4 * hh);
#pragma unroll
            for (int j = 0; j < 4; ++j) { const int i = 4 * g4 + j, sl = 8 * g4 + 4 * hh + j; const float dec = ex2(__builtin_fmaf(as4[j], -LOG2E, acl)); const float v = x[i] * dec; x[i] = (diag && sl > r) ? 0.f : v; } }
#pragma unroll
        for (int sp = 0; sp < 2; ++sp) {
            const bf16x8 pf = pack8(x, sp);
            const unsigned char* vb = Xs + (size_t)(s0 + 16 * sp + 4 * hh + q) * 144 + 32 * blk + 8 * p;
            y0 = MFMA32(cat8(tr_read(vb), tr_read(vb + 8 * 144)), pf, y0);
            y1 = MFMA32(cat8(tr_read(vb + 64), tr_read(vb + 8 * 144 + 64)), pf, y1);
        }
    }
    {
        const float Dk = d_skip[h];
        bf16_t* xrow = conv + (size_t)(row0 + l0 + r) * 2048 + h * 64;
        u32x2 xa[4], xb2[4];
#pragma unroll
        for (int ig = 0; ig < 4; ++ig) { xa[ig] = *(const u32x2*)(xrow + 8 * ig + 4 * hh); xb2[ig] = *(const u32x2*)(xrow + 32 + 8 * ig + 4 * hh); }
#pragma unroll
        for (int ig = 0; ig < 4; ++ig) {
            const u32x2 a = xa[ig], b = xb2[ig]; u32x2 w;
            w.x = pk2(y0[4 * ig] + Dk * bflo(a.x), y0[4 * ig + 1] + Dk * bfhi(a.x)); w.y = pk2(y0[4 * ig + 2] + Dk * bflo(a.y), y0[4 * ig + 3] + Dk * bfhi(a.y)); *(u32x2*)(xrow + 8 * ig + 4 * hh) = w;
            w.x = pk2(y1[4 * ig] + Dk * bflo(b.x), y1[4 * ig + 1] + Dk * bfhi(b.x)); w.y = pk2(y1[4 * ig + 2] + Dk * bflo(b.y), y1[4 * ig + 3] + Dk * bfhi(b.y)); *(u32x2*)(xrow + 32 + 8 * ig + 4 * hh) = w;
        }
    }
    __syncthreads();
    {
        const float last = acs_s[255];
#pragma unroll
        for (int i = 0; i < 4; ++i) { const int e = tid + 512 * i, row = e >> 3, ck = e & 7; u32x4* pp = (u32x4*)(Xs + row * 144 + ck * 16);
            const u32x4 raw = *pp; const float dv = ex2((last - acs_s[row]) * LOG2E);
            u32x4 w; w.x = pk2(bflo(raw.x) * dv, bfhi(raw.x) * dv); w.y = pk2(bflo(raw.y) * dv, bfhi(raw.y) * dv); w.z = pk2(bflo(raw.z) * dv, bfhi(raw.z) * dv); w.w = pk2(bflo(raw.w) * dv, bfhi(raw.w) * dv);
            *pp = w; }
    }
    __syncthreads();
    {
        const int pb = wave & 1, nb = wave >> 1;
        f32x16 sa = zero16(), sa2 = zero16();
#pragma unroll 4
        for (int ks = 0; ks < 16; ks += 2) {
            const int rl = 16 * ks + 8 * hh + q;
            const unsigned char* xa = Xs + (size_t)rl * 144 + (32 * pb + 16 * blk) * 2 + 8 * p;
            const unsigned char* ba = Bs + (size_t)rl * 272 + (32 * nb + 16 * blk) * 2 + 8 * p;
            sa = MFMA32(cat8(tr_read(xa), tr_read(xa + 4 * 144)), cat8(tr_read(ba), tr_read(ba + 4 * 272)), sa);
            sa2 = MFMA32(cat8(tr_read(xa + 16 * 144), tr_read(xa + 20 * 144)), cat8(tr_read(ba + 16 * 272), tr_read(ba + 20 * 272)), sa2);
        }
        sa += sa2;
        float* so = states + (size_t)(bc * 16 + h) * 8192 + 32 * nb + r;
#pragma unroll
        for (int i = 0; i < 16; ++i) so[(32 * pb + crow(i, hh)) * 128] = sa[i];
    }
    __syncthreads();
}

DI void ssd_final_item(unsigned char* lds, const bf16_t* conv, const bf16_t* proj, bf16_t* mixed, const float* acs, const float* states, const float* normw, int item, int tid, int wave, int lane) {
    const int g = item & 3, h2 = (item >> 2) & 1, bc = item >> 3, c = bc & 15, bl = bc >> 4, row0 = bc * 256 + 128 * h2;
    const int r = lane & 31, hh = lane >> 5, grp = wave >> 2, lt = wave & 3, gt = tid & 255;
    unsigned char* Zs = lds + 4 * 17408 + grp * (2 * 128 * 144); unsigned char* Ys = Zs + 128 * 144;
    float* ssx = (float*)(lds + 4 * 17408 + 4 * 128 * 144);
    float* nws = ssx + 256;
    if (tid < 64) ((f32x4*)nws)[tid] = ((const f32x4*)(normw + g * 256))[tid];
    const int srow = gt >> 3, sck = gt & 7;
    u32x4 zr[4], yr[4];
#pragma unroll
    for (int i = 0; i < 4; ++i) { zr[i] = *(const u32x4*)(proj + (size_t)(row0 + srow + 32 * i) * N0 + Z_OFF + (g * 4 + 2 * grp) * 64 + sck * 8); yr[i] = *(const u32x4*)(conv + (size_t)(row0 + srow + 32 * i) * 2048 + (g * 4 + 2 * grp) * 64 + sck * 8); }
    {
        const float* sb = states + (size_t)((bl * 16 + c) * 16 + g * 4) * 8192;
        f32x4 ev[16];
#pragma unroll
        for (int i = 0; i < 16; ++i) ev[i] = (c > 0) ? *(const f32x4*)(sb + (size_t)(i >> 2) * 8192 + (size_t)((tid + 512 * i) & 2047) * 4) : (f32x4){0.f, 0.f, 0.f, 0.f};
#pragma unroll
        for (int i = 0; i < 16; ++i) { const int idx = (tid + 512 * i) & 2047, pp = idx >> 5, n4 = idx & 31;
            u32x2 w; w.x = pk2(ev[i].x, ev[i].y); w.y = pk2(ev[i].z, ev[i].w);
            *(u32x2*)(lds + (i >> 2) * 17408 + pp * 272 + n4 * 8) = w; }
    }
    const int lr = 32 * lt + r, lrow = row0 + lr;
    bf16x8 cf[8];
#pragma unroll
    for (int kk = 0; kk < 8; ++kk) cf[kk] = *(const bf16x8*)(conv + (size_t)lrow * 2048 + 1536 + g * 128 + 16 * kk + 8 * hh);
    unsigned ypx[2][2][4], ypy[2][2][4]; float ss = 0.f;
#pragma unroll
    for (int j = 0; j < 2; ++j) {
        const int hd = 2 * grp + j;
#pragma unroll
        for (int i = 0; i < 4; ++i) { *(u32x4*)(Zs + (srow + 32 * i) * 144 + sck * 16) = zr[i]; *(u32x4*)(Ys + (srow + 32 * i) * 144 + sck * 16) = yr[i]; }
        __syncthreads();
        if (j == 0) {
#pragma unroll
            for (int i = 0; i < 4; ++i) { zr[i] = *(const u32x4*)(proj + (size_t)(row0 + srow + 32 * i) * N0 + Z_OFF + (g * 4 + hd + 1) * 64 + sck * 8); yr[i] = *(const u32x4*)(conv + (size_t)(row0 + srow + 32 * i) * 2048 + (g * 4 + hd + 1) * 64 + sck * 8); }
        }
        const float wst = __expf(acs[(size_t)lrow * 16 + g * 4 + hd]);
#pragma unroll
        for (int pb = 0; pb < 2; ++pb) {
            f32x16 acc = zero16();
#pragma unroll
            for (int kk = 0; kk < 8; ++kk) { const bf16x8 a = *(const bf16x8*)(lds + hd * 17408 + (32 * pb + r) * 272 + (16 * kk + 8 * hh) * 2); acc = MFMA32(a, cf[kk], acc); }
#pragma unroll
            for (int ig = 0; ig < 4; ++ig) {
                const int off = lr * 144 + (32 * pb + 8 * ig + 4 * hh) * 2;
                const u32x2 yd = *(const u32x2*)(Ys + off), zz = *(const u32x2*)(Zs + off);
                const float ydv[4] = {bflo(yd.x), bfhi(yd.x), bflo(yd.y), bfhi(yd.y)}, zv[4] = {bflo(zz.x), bfhi(zz.x), bflo(zz.y), bfhi(zz.y)};
                float v[4];
#pragma unroll
                for (int t = 0; t < 4; ++t) { v[t] = (ydv[t] + acc[4 * ig + t] * wst) * silu_f(zv[t]); ss += v[t] * v[t]; }
                ypx[j][pb][ig] = pk2(v[0], v[1]); ypy[j][pb][ig] = pk2(v[2], v[3]);
            }
        }
        __syncthreads();
    }
    ss += __shfl_xor(ss, 32);
    if (hh == 0) ssx[wave * 32 + r] = ss;
    __syncthreads();
    const float rstd = rsqrtf((ss + ssx[(wave ^ 4) * 32 + r]) * (1.f / 256.f) + EPS);
    __syncthreads();
    unsigned char* Os = lds;
#pragma unroll
    for (int j = 0; j < 2; ++j)
#pragma unroll
        for (int pb = 0; pb < 2; ++pb)
#pragma unroll
            for (int ig = 0; ig < 4; ++ig) {
                const int col = (2 * grp + j) * 64 + 32 * pb + 8 * ig + 4 * hh;
                const f32x4 nw = *(const f32x4*)(nws + col);
                const unsigned yx = ypx[j][pb][ig], yy = ypy[j][pb][ig];
                u32x2 w; w.x = pk2(bflo(yx) * rstd * nw.x, bfhi(yx) * rstd * nw.y); w.y = pk2(bflo(yy) * rstd * nw.z, bfhi(yy) * rstd * nw.w);
                *(u32x2*)(Os + lr * 528 + col * 2) = w;
            }
    __syncthreads();
#pragma unroll
    for (int i = 0; i < 8; ++i) { const int e = tid + 512 * i, row = e >> 5, ck = e & 31;
        *(u32x4*)(mixed + (size_t)(row0 + row) * 1536 + g * 256 + ck * 8) = *(const u32x4*)(Os + row * 528 + ck * 16); }
    __syncthreads();
}

DI void dil_merge_item(const bf16_t* og, const float* lse, const bf16_t* proj, bf16_t* mixed, int row, int lane) {
    const int slot = lane >> 3, ck = lane & 7;
    float lv[3], o[8];
#pragma unroll
    for (int gi = 0; gi < 3; ++gi) lv[gi] = lse[((size_t)gi * TS + row) * 8 + slot];
    const float mx = fmaxf(lv[0], fmaxf(lv[1], lv[2]));
    float w[3], wsum = 0.f;
#pragma unroll
    for (int gi = 0; gi < 3; ++gi) { w[gi] = __expf(lv[gi] - mx); wsum += w[gi]; }
    const float inv = 1.f / wsum;
#pragma unroll
    for (int j = 0; j < 8; ++j) o[j] = 0.f;
#pragma unroll
    for (int gi = 0; gi < 3; ++gi) { const u32x4 raw = *(const u32x4*)(og + ((size_t)gi * TS + row) * 512 + slot * 64 + ck * 8); const float ww = w[gi] * inv;
        o[0] += ww * bflo(raw.x); o[1] += ww * bfhi(raw.x); o[2] += ww * bflo(raw.y); o[3] += ww * bfhi(raw.y); o[4] += ww * bflo(raw.z); o[5] += ww * bfhi(raw.z); o[6] += ww * bflo(raw.w); o[7] += ww * bfhi(raw.w); }
    const u32x4 gr = *(const u32x4*)(proj + (size_t)row * N0 + G_OFF + slot * 64 + ck * 8);
    const float gv[8] = {bflo(gr.x), bfhi(gr.x), bflo(gr.y), bfhi(gr.y), bflo(gr.z), bfhi(gr.z), bflo(gr.w), bfhi(gr.w)};
#pragma unroll
    for (int j = 0; j < 8; ++j) o[j] *= silu_f(gv[j]);
    u32x4 wv; wv.x = pk2(o[0], o[1]); wv.y = pk2(o[2], o[3]); wv.z = pk2(o[4], o[5]); wv.w = pk2(o[6], o[7]);
    *(u32x4*)(mixed + (size_t)row * 1536 + 1024 + slot * 64 + ck * 8) = wv;
}

DI void moba_gate_item(float* kms  , bf16_t* proj, const float* kmean, unsigned* sel, const float* qnw, const float* rope, int item, int lane) {
    const int bh = item >> 6, grp = item & 63, b = bh >> 4, h = bh & 15, t = grp * 64 + lane, ib = grp >> 2;
    {
        const f32x4* kp = (const f32x4*)(kmean + (size_t)bh * 2048);
        f32x4 kv[4], kw[4];
#pragma unroll
        for (int c = 0; c < 4; ++c) { const int e = c * 64 + lane, n = e >> 4, d4 = e & 15; kv[c] = kp[n * 32 + d4]; kw[c] = kp[n * 32 + 16 + d4]; }
#pragma unroll
        for (int c = 0; c < 4; ++c) ((f32x4*)kms)[c * 64 + lane] = (kv[c] + kw[c]) * (1.f / 256.f);
    }
    float qv[64];
    {
        u32x4* qp = (u32x4*)(proj + (size_t)(b * SEQ + t) * N1 + h * 64);
        float ss = 0.f;
#pragma unroll
        for (int c = 0; c < 8; ++c) { const u32x4 raw = qp[c]; qv[8 * c] = bflo(raw.x); qv[8 * c + 1] = bfhi(raw.x); qv[8 * c + 2] = bflo(raw.y); qv[8 * c + 3] = bfhi(raw.y); qv[8 * c + 4] = bflo(raw.z); qv[8 * c + 5] = bfhi(raw.z); qv[8 * c + 6] = bflo(raw.w); qv[8 * c + 7] = bfhi(raw.w); }
#pragma unroll
        for (int j = 0; j < 64; ++j) ss += qv[j] * qv[j];
        const float rn = rsqrtf(ss * (1.f / 64.f) + EPS) * 0.125f;
#pragma unroll
        for (int c = 0; c < 16; ++c) { const f32x4 w4 = *(const f32x4*)(qnw + 4 * c); qv[4 * c] *= rn * w4.x; qv[4 * c + 1] *= rn * w4.y; qv[4 * c + 2] *= rn * w4.z; qv[4 * c + 3] *= rn * w4.w; }
        const f32x4* rp = (const f32x4*)(rope + t * 16);
        const f32x4 c0 = rp[0], c1 = rp[1], s0 = rp[2], s1 = rp[3];
        const float cs[8] = {c0.x, c0.y, c0.z, c0.w, c1.x, c1.y, c1.z, c1.w}, sn[8] = {s0.x, s0.y, s0.z, s0.w, s1.x, s1.y, s1.z, s1.w};
#pragma unroll
        for (int j = 0; j < 8; ++j) { const float x1 = qv[j], x2 = qv[8 + j]; qv[j] = x1 * cs[j] - x2 * sn[j]; qv[8 + j] = x2 * cs[j] + x1 * sn[j]; }
#pragma unroll
        for (int c = 0; c < 8; ++c) { u32x4 w; w.x = pk2(qv[8 * c], qv[8 * c + 1]); w.y = pk2(qv[8 * c + 2], qv[8 * c + 3]); w.z = pk2(qv[8 * c + 4], qv[8 * c + 5]); w.w = pk2(qv[8 * c + 6], qv[8 * c + 7]); qp[c] = w;
            qv[8 * c] = bflo(w.x); qv[8 * c + 1] = bfhi(w.x); qv[8 * c + 2] = bflo(w.y); qv[8 * c + 3] = bfhi(w.y); qv[8 * c + 4] = bflo(w.z); qv[8 * c + 5] = bfhi(w.z); qv[8 * c + 6] = bflo(w.w); qv[8 * c + 7] = bfhi(w.w); }
    }
    LDS_WAIT();
    float v1 = -INFINITY, v2 = -INFINITY, v3 = -INFINITY; int i1 = 255, i2 = 255, i3 = 255;
    for (int n = 0; n < ib; ++n) {
        const f32x4* km = (const f32x4*)(kms + n * 64);
        float d0 = 0.f, d1 = 0.f;
#pragma unroll
        for (int c = 0; c < 16; c += 2) { const f32x4 a = km[c], bq = km[c + 1];
            d0 += (qv[4 * c] * a.x + qv[4 * c + 1] * a.y) + (qv[4 * c + 2] * a.z + qv[4 * c + 3] * a.w);
            d1 += (qv[4 * c + 4] * bq.x + qv[4 * c + 5] * bq.y) + (qv[4 * c + 6] * bq.z + qv[4 * c + 7] * bq.w); }
        const float dot = d0 + d1;
        if (dot > v1) { v3 = v2; i3 = i2; v2 = v1; i2 = i1; v1 = dot; i1 = n; }
        else if (dot > v2) { v3 = v2; i3 = i2; v2 = dot; i2 = n; }
        else if (dot > v3) { v3 = dot; i3 = n; }
    }
    sel[(size_t)bh * SEQ + t] = (unsigned)i1 | ((unsigned)i2 << 8) | ((unsigned)i3 << 16);
    LDS_WAIT();
}
DI void stage_kv(unsigned char* Ks, unsigned char* Vs, const bf16_t* proj, int rowbase, int h, int tid) {
    const int srow = tid >> 3, sck = tid & 7;
    const bf16_t* src = proj + (size_t)(rowbase + srow) * N1 + h * 64 + sck * 8;
    u32x4 pk[4], pv[4];
#pragma unroll
    for (int i = 0; i < 4; ++i) { pk[i] = *(const u32x4*)(src + (size_t)i * 64 * N1 + 1024); pv[i] = *(const u32x4*)(src + (size_t)i * 64 * N1 + 2048); }
#pragma unroll
    for (int i = 0; i < 4; ++i) { *(u32x4*)(Ks + (srow + 64 * i) * 144 + sck * 16) = pk[i]; *(u32x4*)(Vs + (srow + 64 * i) * 144 + sck * 16) = pv[i]; }
}
DI void moba_sel_item(unsigned char* lds, const bf16_t* proj, const unsigned* sel, bf16_t* part01, bf16_t* part2, float* lsep, float smax, int b, int h, int n, int tid, int wave, int lane) {
    const int r = lane & 31, hh = lane >> 5;
    unsigned char* Ks = lds; unsigned char* Vs = lds + 256 * 144;
    unsigned short* list = (unsigned short*)(lds + 2 * 256 * 144); unsigned* cnt = (unsigned*)(lds + 2 * 256 * 144 + 8192);
    __syncthreads();
    if (tid == 0) *cnt = 0u;
    stage_kv(Ks, Vs, proj, b * SEQ + n * 256, h, tid);
    __syncthreads();
    const unsigned* selrow = sel + (size_t)(b * 16 + h) * SEQ;
    {
        unsigned sw[8];
#pragma unroll
        for (int k = 0; k < 8; ++k) { const int c = (n + 1) * 256 + tid + NTHREADS * k; sw[k] = (c < SEQ) ? selrow[c] : 0xFFFFFFFFu; }
#pragma unroll
        for (int k = 0; k < 8; ++k) {
            const int c = (n + 1) * 256 + tid + NTHREADS * k;
            const unsigned s = sw[k];
            const int rho = ((s & 0xFFu) == (unsigned)n) ? 0 : (((s >> 8) & 0xFFu) == (unsigned)n) ? 1 : (((s >> 16) & 0xFFu) == (unsigned)n) ? 2 : -1;
            const unsigned long long mask = __ballot(rho >= 0);
            if (mask != 0ull) {
                unsigned pos0 = 0u;
                if (lane == 0) pos0 = atomicAdd(cnt, (unsigned)__popcll(mask));
                pos0 = (unsigned)__builtin_amdgcn_readfirstlane((int)pos0);
                if (rho >= 0) list[pos0 + (unsigned)__popcll(mask & ((1ull << lane) - 1ull))] = (unsigned short)((c & 0xFFF) | (rho << 12));
            }
        }
    }
    __syncthreads();
    const int total = (int)*cnt;
    bf16x8 qn[4]; unsigned entn = 0u;
    if (32 * wave < total) { const int e = 32 * wave + r; entn = list[e < total ? e : 0];
#pragma unroll
        for (int kk = 0; kk < 4; ++kk) qn[kk] = *(const bf16x8*)(proj + (size_t)(b * SEQ + (entn & 0xFFF)) * N1 + h * 64 + 16 * kk + 8 * hh); }
    for (int k = wave; 32 * k < total; k += NWAVES) {
        const int e = 32 * k + r; const bool valid = e < total;
        const unsigned ent = entn; const int t = ent & 0xFFF, rho = ent >> 12;
        const int qrow = b * SEQ + t;
        bf16x8 qf[4];
#pragma unroll
        for (int kk = 0; kk < 4; ++kk) qf[kk] = qn[kk];
        if (32 * (k + NWAVES) < total) { const int e2 = 32 * (k + NWAVES) + r; entn = list[e2 < total ? e2 : 0];
#pragma unroll
            for (int kk = 0; kk < 4; ++kk) qn[kk] = *(const bf16x8*)(proj + (size_t)(b * SEQ + (entn & 0xFFF)) * N1 + h * 64 + 16 * kk + 8 * hh); }
        float l = 0.f; f32x16 o0 = zero16(), o1 = zero16();
        {
            const float shl = smax * LOG2E;
            f32x16 sa = qk_tile(Ks, 0, qf, lane), sb = qk_tile(Ks, 32, qf, lane);
            bf16x8 pfp[4];
#pragma unroll
            for (int t = 0; t < 4; ++t) {
                f32x16 na = sa, nb = sb;
                if (t < 3) { na = qk_tile(Ks, 64 * t + 64, qf, lane); nb = qk_tile(Ks, 64 * t + 96, qf, lane); }
                bf16x8 pfc[4];
                softmax_exp2t(sa, sb, l, pfc, shl);
                if (t > 0) pv_mfma2t(pfp, o0, o1, Vs, 64 * (t - 1), lane);
                SCHED_MIX(16);
#pragma unroll
                for (int j = 0; j < 4; ++j) pfp[j] = pfc[j];
                sa = na; sb = nb;
            }
            pv_mfma2t(pfp, o0, o1, Vs, 192, lane);
        }
        l += __shfl_xor(l, 32);
        const float inv = 1.f / l;
        if (valid) {
            bf16_t* orow = (rho < 2 ? part01 + (size_t)rho * T * 1024 : part2) + (size_t)qrow * 1024 + h * 64;
#pragma unroll
            for (int ig = 0; ig < 4; ++ig) {
                u32x2 w; w.x = pk2(o0[4 * ig] * inv, o0[4 * ig + 1] * inv); w.y = pk2(o0[4 * ig + 2] * inv, o0[4 * ig + 3] * inv); *(u32x2*)(orow + 8 * ig + 4 * hh) = w;
                w.x = pk2(o1[4 * ig] * inv, o1[4 * ig + 1] * inv); w.y = pk2(o1[4 * ig + 2] * inv, o1[4 * ig + 3] * inv); *(u32x2*)(orow + 32 + 8 * ig + 4 * hh) = w;
            }
            if (hh == 0) lsep[((size_t)rho * T + qrow) * 16 + h] = smax + __logf(l);
        }
    }
}
DI void moba_own_pair(unsigned char* lds, bf16_t* proj, const unsigned* sel, const bf16_t* part01, const bf16_t* part2, const float* lsep, float smax, int b, int h, int iA, int iB, int tid, int wave, int lane) {
    const int r = lane & 31, hh = lane >> 5;
    __syncthreads();
    stage_kv(lds, lds + 256 * 144, proj, b * SEQ + iA * 256, h, tid);
    stage_kv(lds + 2 * 256 * 144, lds + 3 * 256 * 144, proj, b * SEQ + iB * 256, h, tid);
    __syncthreads();
#pragma unroll 1
    for (int sub = 0; sub < 2; ++sub) {
        const int rt = sub ? 7 - wave : wave, ib = sub ? iB : iA;
        const unsigned char* Kc = lds + sub * (2 * 256 * 144); const unsigned char* Vc = Kc + 256 * 144;
        const int qrow = b * SEQ + ib * 256 + 32 * rt + r;
        bf16x8 qf[4];
#pragma unroll
        for (int kk = 0; kk < 4; ++kk) qf[kk] = *(const bf16x8*)(proj + (size_t)qrow * N1 + h * 64 + 16 * kk + 8 * hh);
        const unsigned s = sel[(size_t)(b * 16 + h) * SEQ + ib * 256 + 32 * rt + r];
        float l = 0.f; f32x16 o0 = zero16(), o1 = zero16();
        const int nt = rt + 1;
        int t = 0;
        for (; t + 1 < nt; t += 2) {
            f32x16 sa = qk_tile(Kc, 32 * t, qf, lane), sb = qk_tile(Kc, 32 * t + 32, qf, lane);
            if (t + 1 == rt) mask_le(sb, lane);
            softmax_fs2(sa, sb, l, o0, o1, Vc, 32 * t, lane, smax * LOG2E);
        }
        if (t < nt) { f32x16 sx = qk_tile(Kc, 32 * t, qf, lane); mask_le(sx, lane); softmax_fs1(sx, l, o0, o1, Vc, 32 * t, lane, smax * LOG2E); }
        l += __shfl_xor(l, 32);
        const float lse_own = smax + __logf(l);
        float lv[3]; bool ok[3]; float mx = lse_own;
#pragma unroll
        for (int rho = 0; rho < 3; ++rho) { ok[rho] = ((s >> (8 * rho)) & 0xFFu) != 0xFFu; lv[rho] = ok[rho] ? lsep[((size_t)rho * T + qrow) * 16 + h] : -INFINITY; mx = fmaxf(mx, lv[rho]); }
        float wr[3]; const float wo = __expf(lse_own - mx); float den = wo;
#pragma unroll
        for (int rho = 0; rho < 3; ++rho) { wr[rho] = ok[rho] ? __expf(lv[rho] - mx) : 0.f; den += wr[rho]; }
        const float rden = 1.f / den, so = wo * rden / l;
#pragma unroll
        for (int rho = 0; rho < 3; ++rho) wr[rho] *= rden;
        __syncthreads();
        unsigned char* scr = lds + sub * (2 * 256 * 144) + wave * 9216;
        const int rowb = b * SEQ + ib * 256 + 32 * rt, lr8 = lane >> 3, lck = lane & 7;
        float v[2][4][4];
#pragma unroll
        for (int ig = 0; ig < 4; ++ig)
#pragma unroll
            for (int j = 0; j < 4; ++j) { v[0][ig][j] = o0[4 * ig + j] * so; v[1][ig][j] = o1[4 * ig + j] * so; }
        {
            u32x4 ta[4], tb[4];
#pragma unroll
            for (int j = 0; j < 4; ++j) { const size_t ro = (size_t)(rowb + 8 * j + lr8) * 1024 + h * 64 + lck * 8; ta[j] = *(const u32x4*)(part01 + ro); tb[j] = *(const u32x4*)(part01 + (size_t)T * 1024 + ro); }
#pragma unroll
            for (int j = 0; j < 4; ++j) { *(u32x4*)(scr + (8 * j + lr8) * 136 + lck * 16) = ta[j]; *(u32x4*)(scr + 4352 + (8 * j + lr8) * 136 + lck * 16) = tb[j]; }
            LDS_WAIT();
#pragma unroll
            for (int half = 0; half < 2; ++half)
#pragma unroll
                for (int ig = 0; ig < 4; ++ig) { const int off = r * 136 + (32 * half + 8 * ig + 4 * hh) * 2;
                    const u32x2 p0 = *(const u32x2*)(scr + off), p1 = *(const u32x2*)(scr + 4352 + off);
                    v[half][ig][0] += (ok[0] ? wr[0] * bflo(p0.x) : 0.f) + (ok[1] ? wr[1] * bflo(p1.x) : 0.f); v[half][ig][1] += (ok[0] ? wr[0] * bfhi(p0.x) : 0.f) + (ok[1] ? wr[1] * bfhi(p1.x) : 0.f);
                    v[half][ig][2] += (ok[0] ? wr[0] * bflo(p0.y) : 0.f) + (ok[1] ? wr[1] * bflo(p1.y) : 0.f); v[half][ig][3] += (ok[0] ? wr[0] * bfhi(p0.y) : 0.f) + (ok[1] ? wr[1] * bfhi(p1.y) : 0.f); }
            LDS_WAIT();
        }
        {
            u32x4 ta[4], tb[4];
#pragma unroll
            for (int j = 0; j < 4; ++j) { ta[j] = *(const u32x4*)(part2 + (size_t)(rowb + 8 * j + lr8) * 1024 + h * 64 + lck * 8); tb[j] = *(const u32x4*)(proj + (size_t)(rowb + 8 * j + lr8) * N1 + 3072 + h * 64 + lck * 8); }
#pragma unroll
            for (int j = 0; j < 4; ++j) { *(u32x4*)(scr + (8 * j + lr8) * 136 + lck * 16) = ta[j]; *(u32x4*)(scr + 4352 + (8 * j + lr8) * 136 + lck * 16) = tb[j]; }
            LDS_WAIT();
            u32x2 res[2][4];
#pragma unroll
            for (int half = 0; half < 2; ++half)
#pragma unroll
                for (int ig = 0; ig < 4; ++ig) { const int off = r * 136 + (32 * half + 8 * ig + 4 * hh) * 2;
                    const u32x2 p2 = *(const u32x2*)(scr + off), gg = *(const u32x2*)(scr + 4352 + off);
                    const float a0 = v[half][ig][0] + (ok[2] ? wr[2] * bflo(p2.x) : 0.f), a1 = v[half][ig][1] + (ok[2] ? wr[2] * bfhi(p2.x) : 0.f), a2 = v[half][ig][2] + (ok[2] ? wr[2] * bflo(p2.y) : 0.f), a3 = v[half][ig][3] + (ok[2] ? wr[2] * bfhi(p2.y) : 0.f);
                    res[half][ig].x = pk2(a0 * silu_f(bflo(gg.x)), a1 * silu_f(bfhi(gg.x))); res[half][ig].y = pk2(a2 * silu_f(bflo(gg.y)), a3 * silu_f(bfhi(gg.y))); }
            LDS_WAIT();
#pragma unroll
            for (int half = 0; half < 2; ++half)
#pragma unroll
                for (int ig = 0; ig < 4; ++ig) *(u32x2*)(scr + r * 136 + (32 * half + 8 * ig + 4 * hh) * 2) = res[half][ig];
            LDS_WAIT();
#pragma unroll
            for (int j = 0; j < 4; ++j) *(u32x4*)(proj + (size_t)(rowb + 8 * j + lr8) * N1 + h * 64 + lck * 8) = *(const u32x4*)(scr + (8 * j + lr8) * 136 + lck * 16);
            LDS_WAIT();
        }
    }
}

#define XB_XCNT(j) (64 * (j))
#define XB_XSUB(j) (1024 + 64 * (j))
#define XB_XGEN(j) (2048 + 64 * (j))
#define XB_TOP 3072
#define XB_TOPGEN 3136
#define XB_WORDS 3200
DI unsigned xb_ld(unsigned* p) { return __hip_atomic_load(p, __ATOMIC_RELAXED, __HIP_MEMORY_SCOPE_AGENT); }
DI unsigned xb_add(unsigned* p, unsigned v) { return __hip_atomic_fetch_add(p, v, __ATOMIC_RELAXED, __HIP_MEMORY_SCOPE_AGENT); }
DI unsigned xb_xcc_id() { return (unsigned)__builtin_amdgcn_s_getreg((3 << 11) | 20) & 0xFu; }
#define XB_SPIN(cond) do { unsigned sp_ = 0; while (cond) { __builtin_amdgcn_s_sleep(1); if (++sp_ > (1u << 22)) break; } } while (0)
DI void grid_barrier(unsigned* bar, const volatile unsigned* st, bool leader) {
    asm volatile("s_waitcnt vmcnt(0) lgkmcnt(0)" ::: "memory");
    __syncthreads();
    if (leader) {
        const unsigned x = st[0], nloc = st[1], nx = st[2];
        const unsigned old = xb_add(&bar[XB_XSUB(x)], 1u), gen = old / nloc;
        if (old + 1u == (gen + 1u) * nloc) {
            __builtin_amdgcn_fence(__ATOMIC_RELEASE, "agent");
            asm volatile("s_waitcnt vmcnt(0)" ::: "memory");
            const unsigned og = xb_add(&bar[XB_TOP], 1u), tg = og / nx;
            if (og + 1u == (tg + 1u) * nx) xb_add(&bar[XB_TOPGEN], 1u);
            else XB_SPIN(xb_ld(&bar[XB_TOPGEN]) == tg);
            __builtin_amdgcn_fence(__ATOMIC_ACQUIRE, "agent");
            xb_add(&bar[XB_XGEN(x)], 1u);
            asm volatile("s_waitcnt vmcnt(0)" ::: "memory");
        } else {
            XB_SPIN(xb_ld(&bar[XB_XGEN(x)]) == gen);
            __builtin_amdgcn_fence(__ATOMIC_ACQUIRE, "agent");
            asm volatile("s_waitcnt vmcnt(0)" ::: "memory");
        }
    }
    __syncthreads();
}

DI int lane_id_opaque() { int l; asm volatile("v_mbcnt_lo_u32_b32 %0, -1, 0\n\tv_mbcnt_hi_u32_b32 %0, -1, %0" : "=&v"(l)); return l; }
#define PHASE_BEGIN \
    int tid; asm volatile("v_mbcnt_lo_u32_b32 %0, -1, 0\n\tv_mbcnt_hi_u32_b32 %0, -1, %0" : "=&v"(tid)); tid |= wave0 << 6; \
    const int lane = tid & 63, wave = __builtin_amdgcn_readfirstlane(tid >> 6); \
    int bx = blockIdx.x; asm volatile("" : "+s"(bx)); \
    const int G = gridDim.x, gw = bx * NWAVES + wave, NGW = G * NWAVES; \
    size_t zoff_ = 0; asm volatile("" : "+s"(zoff_));     \
    unsigned char* ws = P.ws + zoff_; \
    unsigned char* dob = (unsigned char*)P.out + zoff_; \
    (void)lane; (void)wave; (void)gw; (void)NGW; (void)G; (void)ws; (void)dob;
#define WSP(type, off) ((type*)(ws + (off)))
#define DOP(type, off) ((type*)(dob + (off)))

__global__ void __launch_bounds__(NTHREADS, 2) fwd_kernel(Params P) {
    extern __shared__ __attribute__((aligned(16))) unsigned char lds[];
    cg::grid_group grid = cg::this_grid();
    const int wave0 = __builtin_amdgcn_readfirstlane((int)threadIdx.x >> 6);
#define TID0() (wave0 == 0 && lane_id_opaque() == 0)
    volatile unsigned* xst = (volatile unsigned*)(lds + LDS_BYTES - 16);
#define GSYNC() grid_barrier((unsigned*)(P.ws + WS_BAR), xst, TID0())
    if (TID0()) xb_add((unsigned*)(P.ws + WS_BAR) + XB_XCNT(xb_xcc_id()), 1u);

    {
        PHASE_BEGIN
        float* scr = (float*)(lds + 65536) + wave * (64 * 33);
        constexpr int I0 = 16 * 256, I1 = 24 * 32, I2 = 16 * 128, I3 = 16 * 32;
        for (int it = gw; it < I0 + I1 + I2 + I3; it += NGW) {
            int q = it;
            if (q < I0) { const int kb = q >> 8, nb = q & 255, n0 = 32 * nb; transpose_item(P.e_w_in, 8208, 1024, WSP(bf16_t, WS_W0T), n0, n0 < 3072 ? n0 : n0 + 16, 64 * kb, P.e_norm_w, scr, lane); continue; } q -= I0;
            if (q < I1) { const int kb = q >> 5, nb = q & 31; transpose_item(P.e_w_out, 1024, 1536, WSP(bf16_t, WS_WO0T), 32 * nb, 32 * nb, 64 * kb, nullptr, scr, lane); continue; } q -= I1;
            if (q < I2) { const int kb = q >> 7, nb = q & 127; transpose_item(P.o_w_in, 4096, 1024, WSP(bf16_t, WS_W1T), 32 * nb, 32 * nb, 64 * kb, P.o_norm_w, scr, lane); continue; } q -= I2;
            { const int kb = q >> 5, nb = q & 31; transpose_item(P.o_w_out, 1024, 1024, WSP(bf16_t, WS_WO1T), 32 * nb, 32 * nb, 64 * kb, nullptr, scr, lane); }
        }
        float* rope = WSP(float, WS_ROPE);
        for (int e = bx * NTHREADS + tid; e < SEQ * 8; e += G * NTHREADS) {
            const int pos = e >> 3, i = e & 7;
            const float inv = powf(500000.f, -(float)i * 0.125f), ang = (float)pos * inv;
            double rev = (double)ang * 0.15915494309189535; rev -= rint(rev);
            const float fr = (float)rev;
            rope[pos * 16 + i] = __builtin_amdgcn_cosf(fr); rope[pos * 16 + 8 + i] = __builtin_amdgcn_sinf(fr);
        }
        f32x4* wl = (f32x4*)lds;
        for (int e = tid; e < 4096; e += NTHREADS) { const int k = e >> 2, c4 = e & 3, l = (k & 255) >> 2, t = k & 3, jj = k >> 8;
            wl[((jj * 4 + t) * 4 + c4) * 64 + l] = *(const f32x4*)(P.e_w_in + (size_t)k * 8208 + 3072 + 4 * c4) * P.e_norm_w[k]; }
        __syncthreads();
        rows_phase<true>(P.x, WSP(bf16_t, WS_XB), WSP(float, WS_RSTD), WSP(float, WS_DTRAW), wl, gw, NGW, lane);
    }
    if (P.ws == nullptr) grid.sync();
    if (TID0()) {
        unsigned* bar = (unsigned*)(P.ws + WS_BAR); const unsigned x = xb_xcc_id(); unsigned mine = 1u, cnt = 0u, sum = 0u, sp = 0u;
        for (;;) { sum = 0u; cnt = 0u;
            for (unsigned j = 0; j < 16; ++j) { const unsigned c = xb_ld(&bar[XB_XCNT(j)]); sum += c; cnt += (c > 0u) ? 1u : 0u; if (j == x) mine = c; }
            if (sum == gridDim.x || ++sp > (1u << 22)) break; __builtin_amdgcn_s_sleep(1); }
        xst[0] = x; xst[1] = mine ? mine : 1u; xst[2] = cnt ? cnt : 1u;
    }
    GSYNC();

    for (int sl = 0; sl < 2; ++sl) {
        const size_t R0 = (size_t)sl * TS;
        {
            PHASE_BEGIN
            pg8::Gemm g{WSP(bf16_t, WS_XB) + R0 * D, WSP(bf16_t, WS_W0T), TS, N0, D, D, D}; pg8::StaticOrder S; S.init(TS, N0, G, bx);
            pg8::EpiScaleBf16 E{WSP(bf16_t, WS_PROJ), N0, WSP(float, WS_RSTD) + R0, nullptr};
            pg8::gemm_phase<pg8::EpiScaleBf16, pg8::StaticOrder>((LAS unsigned char*)lds, g, S, E, tid);
        }
        GSYNC();
        {
            PHASE_BEGIN
            constexpr int IB = 512 * 4, IC = 512;
            for (int q = gw; q < IB; q += NGW) conv_item(WSP(bf16_t, WS_PROJ), DOP(bf16_t, DO_CONV), P.e_conv_w, P.e_conv_b, (q >> 2) * 16, (q & 3) * 512, lane);
            if ((gw & 3) == 0) for (int q = gw >> 2; q < IC; q += (NGW + 3) >> 2)
                dt_item(WSP(float, WS_DTRAW) + R0 * 16, DOP(float, DO_DT), DOP(float, DO_ACS), P.e_dt_bias, P.e_a_log, q, lane);
        }
        GSYNC();
        {
            PHASE_BEGIN
            const int nrd = (512 + 768 + G - 1) / G;
            for (int r5 = 0; r5 < nrd; ++r5) {
                const int it = bx + G * ((r5 + (bx >> 5)) % nrd);
                if (it >= 512 + 768) continue;
                if (it < 512) { const int xq = it & 7, rest = it >> 3, X = xq + 8 * (rest >> 2), hd4 = rest & 3;
                    ssd_intra_item(lds, DOP(bf16_t, DO_CONV), DOP(float, DO_DT), DOP(float, DO_ACS), WSP(float, WS_STATES), P.e_d_skip, (X >> 2) * 16 + (X & 3) * 4 + hd4, tid, wave, lane); }
                else { const int d = it - 512, gi = d >> 8, w8 = d & 255, xq = w8 & 7, rest = w8 >> 3, tps = 16 >> (2 * gi);
                    dil_attn_item(lds, WSP(bf16_t, WS_PROJ), DOP(bf16_t, DO_OG), DOP(float, DO_LSE), P.e_q_norm, P.e_k_norm, WSP(float, WS_ROPE), (gi << 8) + (xq + 8 * (rest / tps)) * tps + (rest & (tps - 1)), tid, wave, lane); }
            }
        }
        GSYNC();
        {
            PHASE_BEGIN
            float* states = WSP(float, WS_STATES); const float* acs = DOP(float, DO_ACS);
            typedef float f32x2v __attribute__((ext_vector_type(2)));
            for (int e = bx * NTHREADS + tid; e < 32 * 4096; e += G * NTHREADS) {
                const int bh = e >> 12, idx = e & 4095, bl = bh >> 4, h = bh & 15;
                float* base = states + (size_t)(bl * 256 + h) * 8192 + (size_t)idx * 2;
                f32x2v sv[15]; float av[15];
#pragma unroll
                for (int c = 0; c < 15; ++c) { sv[c] = *(const f32x2v*)(base + (size_t)c * 16 * 8192); av[c] = acs[(size_t)(bl * SEQ + c * 256 + 255) * 16 + h]; }
                f32x2v E = (f32x2v){0.f, 0.f};
#pragma unroll
                for (int c = 0; c < 15; ++c) { const float dec = __expf(av[c]); E = E * dec + sv[c]; *(f32x2v*)(base + (size_t)(c + 1) * 16 * 8192) = E; }
            }
        }
        GSYNC();
        {
            PHASE_BEGIN
            bf16_t* mixed = WSP(bf16_t, WS_MIXED) + R0 * 1536;
            if (bx & 1) for (int row = gw; row < TS; row += NGW) dil_merge_item(DOP(bf16_t, DO_OG), DOP(float, DO_LSE), WSP(bf16_t, WS_PROJ), mixed, row, lane);
            for (int it = bx; it < 256; it += G) { const int xq = it & 7, rest = it >> 3, X = xq + 8 * (rest >> 1), h2 = rest & 1;
                ssd_final_item(lds, DOP(bf16_t, DO_CONV), WSP(bf16_t, WS_PROJ), mixed, DOP(float, DO_ACS), WSP(float, WS_STATES), P.e_ssd_norm_w, (X >> 2) * 8 + h2 * 4 + (X & 3), tid, wave, lane); }
            if (!(bx & 1)) for (int row = gw; row < TS; row += NGW) dil_merge_item(DOP(bf16_t, DO_OG), DOP(float, DO_LSE), WSP(bf16_t, WS_PROJ), mixed, row, lane);
        }
        GSYNC();
    }
    {
        PHASE_BEGIN
        pg8::Gemm g{WSP(bf16_t, WS_MIXED), WSP(bf16_t, WS_WO0T), T, 1024, 1536, 1536, 1536}; pg8::StaticOrder S; S.init(T, 1024, G, bx);
        pg8::EpiResF32X E{P.x, (float*)dob, WSP(bf16_t, WS_XB), WSP(float, WS_DTRAW), 1024};
        pg8::gemm_phase<pg8::EpiResF32X, pg8::StaticOrder>((LAS unsigned char*)lds, g, S, E, tid);
    }
    GSYNC();
    {
        PHASE_BEGIN
        pg8::Gemm g{WSP(bf16_t, WS_XB), WSP(bf16_t, WS_W1T), T, N1, D, D, D}; pg8::StaticOrder S; S.init(T, N1, G, bx);
        pg8::EpiScaleBf16 E{WSP(bf16_t, WS_PROJ), N1, nullptr, WSP(float, WS_DTRAW)};
        pg8::gemm_phase<pg8::EpiScaleBf16, pg8::StaticOrder>((LAS unsigned char*)lds, g, S, E, tid);
    }
    GSYNC();
    {
        PHASE_BEGIN
        for (int it = gw; it < 2048; it += NGW) { const int half = it & 1, rb = it >> 5, hd = (it >> 1) & 15;
            qk_norm_rope_item(WSP(bf16_t, WS_PROJ), N1, rb * 256 + half * 128, 4, 1024 + hd * 64, P.o_k_norm, 1.f, WSP(float, WS_ROPE), WSP(float, WS_KMEAN) + (size_t)((((rb >> 4) * 16 + hd) * 16 + (rb & 15)) * 2 + half) * 64, lane); }
    }
    GSYNC();
    {
        PHASE_BEGIN
        for (int it = gw; it < 4096; it += NGW) moba_gate_item((float*)(lds + wave * 4096), WSP(bf16_t, WS_PROJ), WSP(float, WS_KMEAN), WSP(unsigned, WS_W0T + (4u << 20)), P.o_q_norm, WSP(float, WS_ROPE), it, lane);
    }
    GSYNC();
    {
        PHASE_BEGIN
        const float smax1 = score_bound(P.o_q_norm, P.o_k_norm, lane);
        for (int it = bx; it < 1024; it += G) {
            const int rd = it >> 8, c = it & 255, qd = c >> 6, bh = c & 63, n = 4 * rd + ((rd & 1) ? 3 - qd : qd);
            if (n < 15) moba_sel_item(lds, WSP(bf16_t, WS_PROJ), WSP(unsigned, WS_W0T + (4u << 20)), WSP(bf16_t, WS_MIXED), WSP(bf16_t, WS_XB), WSP(float, WS_W0T), smax1, bh >> 4, bh & 15, n, tid, wave, lane);
        }
    }
    GSYNC();
    {
        PHASE_BEGIN
        const float smax1 = score_bound(P.o_q_norm, P.o_k_norm, lane);
        for (int it = bx; it < 512; it += G) {
            const int bh = it & 63, j = it >> 6;
            moba_own_pair(lds, WSP(bf16_t, WS_PROJ), WSP(unsigned, WS_W0T + (4u << 20)), WSP(bf16_t, WS_MIXED), WSP(bf16_t, WS_XB), WSP(float, WS_W0T), smax1, bh >> 4, bh & 15, 2 * j, 2 * j + 1, tid, wave, lane);
        }
    }
    GSYNC();
    {
        PHASE_BEGIN
        pg8::Gemm g{WSP(bf16_t, WS_PROJ), WSP(bf16_t, WS_WO1T), T, 1024, 1024, N1, 1024}; pg8::StaticOrder S; S.init(T, 1024, G, bx);
        pg8::EpiResF32 E{(const float*)dob, (float*)dob, 1024};
        pg8::gemm_phase<pg8::EpiResF32, pg8::StaticOrder>((LAS unsigned char*)lds, g, S, E, tid);
    }
}

extern "C" void kernel_launch(void* const* d_in, const int* in_sizes, int n_in, void* d_out, int out_size, void* d_ws, size_t ws_size, hipStream_t stream) {
    static int grid = 0;
    if (grid == 0) {
        if (n_in != 17 || in_sizes[0] != T * D || out_size != T * D || ws_size < WS_END) { fprintf(stderr, "kernel_launch: unexpected shapes (n_in %d, in0 %d, out %d, ws %zu < %zu)\n", n_in, n_in > 0 ? in_sizes[0] : -1, out_size, ws_size, (size_t)WS_END); grid = -1; return; }
        int dev = 0, cus = 0, per_cu = 0;
        hipGetDevice(&dev);
        hipDeviceGetAttribute(&cus, hipDeviceAttributeMultiprocessorCount, dev);
        if (hipFuncSetAttribute((const void*)fwd_kernel, hipFuncAttributeMaxDynamicSharedMemorySize, LDS_BYTES) != hipSuccess) { fprintf(stderr, "kernel_launch: hipFuncSetAttribute failed\n"); grid = -1; return; }
        if (hipOccupancyMaxActiveBlocksPerMultiprocessor(&per_cu, (const void*)fwd_kernel, NTHREADS, LDS_BYTES) != hipSuccess || per_cu < 1) { fprintf(stderr, "kernel_launch: occupancy query gives %d\n", per_cu); per_cu = 1; }
        (void)hipGetLastError();
        grid = cus * 1;
    }
    if (grid < 0) return;
    if (hipMemsetAsync((unsigned char*)d_ws + WS_BAR, 0, 3200 * 4, stream) != hipSuccess) { fprintf(stderr, "kernel_launch: memset failed\n"); return; }
    Params p{};
    const float** pp = (const float**)&p;
    for (int i = 0; i < 17; ++i) pp[i] = (const float*)d_in[i];
    p.out = (float*)d_out; p.ws = (unsigned char*)d_ws;
    void* args[] = {&p};
    hipError_t e = hipLaunchCooperativeKernel((const void*)fwd_kernel, dim3(grid), dim3(NTHREADS), args, LDS_BYTES, stream);
    if (e != hipSuccess) fprintf(stderr, "cooperative launch failed: %s (grid %d)\n", hipGetErrorString(e), grid);
}
```

```cpp
#include <hip/hip_runtime.h>
#include <hip/hip_cooperative_groups.h>
#include <cstdio>
#include <cstdint>
namespace cg = cooperative_groups;

#define LAS __attribute__((address_space(3)))
typedef unsigned short bf16_t;
typedef short bf16x8 __attribute__((ext_vector_type(8)));
typedef short s16x4 __attribute__((ext_vector_type(4)));
typedef float f32x4 __attribute__((ext_vector_type(4)));
typedef float f32x16 __attribute__((ext_vector_type(16)));
typedef unsigned u32x4 __attribute__((ext_vector_type(4)));
typedef unsigned u32x2 __attribute__((ext_vector_type(2)));
#define DI __device__ __forceinline__

constexpr int T = 16384, D = 1024, SEQ = 4096, TS = 8192;
constexpr int N0 = 8192;
constexpr int Z_OFF = 0, XBC_OFF = 1024, Q_OFF = 3072, K_OFF = 4608, V_OFF = 6144, G_OFF = 7680;
constexpr int N1 = 4096;
constexpr int NTHREADS = 512, NWAVES = 8;
constexpr float EPS = 1e-6f, LOG2E = 1.4426950408889634f, LN2 = 0.6931471805599453f;

constexpr size_t WS_W0T = 0;
constexpr size_t WS_WO0T = WS_W0T + (size_t)N0 * D * 2;
constexpr size_t WS_W1T = WS_WO0T + (size_t)1024 * 1536 * 2;
constexpr size_t WS_WO1T = WS_W1T + (size_t)N1 * D * 2;
constexpr size_t WS_XB = WS_WO1T + (size_t)1024 * 1024 * 2;
constexpr size_t WS_PROJ = WS_XB + (size_t)T * D * 2;
constexpr size_t WS_MIXED = WS_PROJ + (size_t)TS * N0 * 2;
constexpr size_t WS_STATES = WS_MIXED + (size_t)T * 1536 * 2;
constexpr size_t WS_RSTD = WS_STATES + (size_t)2 * 16 * 16 * 8192 * 4;
constexpr size_t WS_DTRAW = WS_RSTD + (size_t)T * 4;
constexpr size_t WS_ROPE = WS_DTRAW + (size_t)T * 16 * 4;
constexpr size_t WS_KMEAN = WS_ROPE + (size_t)SEQ * 16 * 4;
constexpr size_t WS_BAR = WS_KMEAN + (size_t)4 * 16 * 16 * 2 * 64 * 4;
constexpr size_t WS_END = WS_BAR + 3200 * 4;
static_assert(WS_END <= (size_t)256 * 1024 * 1024, "workspace");
constexpr size_t DO_CONV = 0;
constexpr size_t DO_OG = DO_CONV + (size_t)TS * 2048 * 2;
constexpr size_t DO_LSE = DO_OG + (size_t)3 * TS * 512 * 2;
constexpr size_t DO_DT = DO_LSE + (size_t)3 * TS * 8 * 4;
constexpr size_t DO_ACS = DO_DT + (size_t)TS * 16 * 4;
static_assert(DO_ACS + (size_t)TS * 16 * 4 <= (size_t)T * D * 4, "d_out scratch");

constexpr int LDS_BYTES = 4 * 256 * 144 + 4096 + 2048;

typedef float f32x2 __attribute__((ext_vector_type(2)));
typedef __bf16 bf16x2_t __attribute__((ext_vector_type(2)));
DI unsigned pk2v(float lo, float hi) { const f32x2 v = {lo, hi}; return __builtin_bit_cast(unsigned, __builtin_convertvector(v, bf16x2_t)); }
DI unsigned pk2(float lo, float hi) { unsigned r; asm("v_cvt_pk_bf16_f32 %0, %1, %2" : "=v"(r) : "v"(lo), "v"(hi)); return r; }
DI float ex2(float x) { return __builtin_amdgcn_exp2f(x); }
DI float bflo(unsigned u) { return __uint_as_float(u << 16); }
DI float bfhi(unsigned u) { return __uint_as_float(u & 0xffff0000u); }
DI float wave_sum(float v) {
#pragma unroll
    for (int o = 1; o < 64; o <<= 1) v += __shfl_xor(v, o);
    return v;
}
DI float silu_f(float v) { return v * __builtin_amdgcn_rcpf(1.f + __expf(-v)); }
DI int crow(int i, int h) { return (i & 3) + 8 * (i >> 2) + 4 * h; }
#define MFMA32(a, b, c) __builtin_amdgcn_mfma_f32_32x32x16_bf16((a), (b), (c), 0, 0, 0)
DI s16x4 tr_read(const unsigned char* p) { return __builtin_amdgcn_ds_read_tr16_b64_v4i16((LAS s16x4*)p); }
DI bf16x8 cat8(s16x4 lo, s16x4 hi) { return __builtin_shufflevector(lo, hi, 0, 1, 2, 3, 4, 5, 6, 7); }
DI bf16x8 pack8(const f32x16& x, int s) {
    u32x4 p; p.x = pk2v(x[8 * s], x[8 * s + 1]); p.y = pk2v(x[8 * s + 2], x[8 * s + 3]); p.z = pk2v(x[8 * s + 4], x[8 * s + 5]); p.w = pk2v(x[8 * s + 6], x[8 * s + 7]);
    return __builtin_bit_cast(bf16x8, p);
}
DI f32x16 zero16() { f32x16 z; for (int i = 0; i < 16; ++i) z[i] = 0.f; return z; }

namespace pg8 {
constexpr int BM = 256, BK = 64, HALF = 128, HTB = HALF * BK * 2, STAGE_BYTES = 8 * HTB, NXCD = 8, WGM = 8;
DI int lds_byte(int r, int c) { const int st = (r >> 4) * 2 + (c >> 5), rr = r & 15, cc = c & 31, ob = rr * 64 + cc * 2; return st * 1024 + (ob ^ (((ob >> 9) & 1) << 5)); }
DI void stage_rc(int b, int& R, int& C) { const int st = b / 1024, sb = b % 1024, swz = sb ^ (((sb >> 9) & 1) << 5); R = (st >> 1) * 16 + swz / 64; C = (st & 1) * 32 + (swz % 64) / 2; }
DI int perm32(int rho) { const int n = rho >> 4, i = rho & 15; return 8 * (i >> 2) + 4 * n + (i & 3); }
struct Unit { int pm, pn; };
struct Gemm { const bf16_t* A; const bf16_t* Bt; int M, N, K, lda, ldb; };
struct StaticOrder {
    int nM, nN, nwg, G, c;
    DI void init(int M, int N, int G_, int c_) { nM = M / BM; nN = N / BM; nwg = nM * nN; G = G_; c = c_; }
    DI bool next(int i, Unit& u) const {
        const long L = (long)i * G + c; if (L >= nwg) return false;
        int wgid = (int)L; { const int q = nwg / NXCD, r = nwg % NXCD, xcd = wgid % NXCD, off = wgid / NXCD; wgid = (xcd < r ? xcd * (q + 1) : r * (q + 1) + (xcd - r) * q) + off; }
        const int nig = WGM * nN, gid = wgid / nig, fm = gid * WGM, gsz = (nM - fm) < WGM ? (nM - fm) : WGM;
        u.pm = fm + ((wgid % nig) % gsz); u.pn = (wgid % nig) / gsz; return true;
    }
};
struct EpiScaleBf16 {
    static constexpr bool PERM = true;
    bf16_t* O; int ldc; const float* rs; const float* psq;
    DI void operator()(const f32x4 (&acc)[2][2][4][2], const Unit& u, int wr, int wc, int fr, int fq) const {
        const int row0 = u.pm * BM + wr * 64 + fr, col0 = u.pn * BM + wc * 32 + 8 * fq;
        float sc[2][4];
        if (rs) {
#pragma unroll
            for (int ai = 0; ai < 2; ++ai)
#pragma unroll
                for (int m = 0; m < 4; ++m) sc[ai][m] = rs[row0 + ai * HALF + m * 16];
        } else {
#pragma unroll
            for (int ai = 0; ai < 2; ++ai) {
                f32x4 pv[4][4];
#pragma unroll
                for (int m = 0; m < 4; ++m) { const f32x4* pp = (const f32x4*)(psq + (size_t)(row0 + ai * HALF + m * 16) * 16);
#pragma unroll
                    for (int j = 0; j < 4; ++j) pv[m][j] = pp[j]; }
#pragma unroll
                for (int m = 0; m < 4; ++m) { const f32x4 a = pv[m][0] + pv[m][1] + pv[m][2] + pv[m][3]; sc[ai][m] = rsqrtf(((a.x + a.y) + (a.z + a.w)) * (1.f / 1024.f) + EPS); }
            }
        }
#pragma unroll
        for (int ai = 0; ai < 2; ++ai)
#pragma unroll
            for (int m = 0; m < 4; ++m) { const int row = row0 + ai * HALF + m * 16; const float s = sc[ai][m];
                bf16_t* rowp = O + (size_t)row * ldc + col0;
#pragma unroll
                for (int bj = 0; bj < 2; ++bj) { const f32x4 v0 = acc[ai][bj][m][0] * s, v1 = acc[ai][bj][m][1] * s;
                    u32x4 w; w.x = pk2(v0[0], v0[1]); w.y = pk2(v0[2], v0[3]); w.z = pk2(v1[0], v1[1]); w.w = pk2(v1[2], v1[3]);
                    *(u32x4*)(rowp + bj * HALF) = w; } }
    }
};
struct EpiResF32X {
    static constexpr bool PERM = false;
    const float* R; float* C; bf16_t* XB; float* psq; int ldc;
    DI void operator()(const f32x4 (&acc)[2][2][4][2], const Unit& u, int wr, int wc, int fr, int fq) const {
        const int row0 = u.pm * BM + wr * 64 + fr, col0 = u.pn * BM + wc * 32 + 4 * fq;
        f32x4 rv[2][2][2][2];
#define EPI_LOAD(buf, q) do { const int ai_ = (q) >> 1, m0_ = ((q) & 1) * 2; _Pragma("unroll") for (int mm = 0; mm < 2; ++mm) _Pragma("unroll") for (int bj = 0; bj < 2; ++bj) _Pragma("unroll") for (int n = 0; n < 2; ++n) \
            rv[buf][mm][bj][n] = *(const f32x4*)(R + (size_t)(row0 + ai_ * HALF + (m0_ + mm) * 16) * ldc + col0 + bj * HALF + n * 16); } while (0)
        EPI_LOAD(0, 0);
#pragma unroll
        for (int q = 0; q < 4; ++q) {
            if (q < 3) { if (q & 1) EPI_LOAD(0, q + 1); else EPI_LOAD(1, q + 1); }
            const int ai = q >> 1, m0 = (q & 1) * 2;
#pragma unroll
            for (int mm = 0; mm < 2; ++mm) { const int m = m0 + mm, row = row0 + ai * HALF + m * 16; const size_t ro = (size_t)row * ldc + col0; float ss = 0.f;
#pragma unroll
                for (int bj = 0; bj < 2; ++bj)
#pragma unroll
                    for (int n = 0; n < 2; ++n) { const size_t idx = ro + bj * HALF + n * 16; const f32x4 v = rv[q & 1][mm][bj][n] + acc[ai][bj][m][n]; *(f32x4*)(C + idx) = v;
                        u32x2 w; w.x = pk2(v.x, v.y); w.y = pk2(v.z, v.w); *(u32x2*)(XB + idx) = w; ss += (v.x * v.x + v.y * v.y) + (v.z * v.z + v.w * v.w); }
                ss += __shfl_xor(ss, 16); ss += __shfl_xor(ss, 32);
                if (fq == 0) psq[(size_t)row * 16 + u.pn * 4 + wc] = ss; }
        }
#undef EPI_LOAD
    }
};
struct EpiResF32 {
    static constexpr bool PERM = false;
    const float* R; float* C; int ldc;
    DI void operator()(const f32x4 (&acc)[2][2][4][2], const Unit& u, int wr, int wc, int fr, int fq) const {
        const int row0 = u.pm * BM + wr * 64 + fr, col0 = u.pn * BM + wc * 32 + 4 * fq;
        f32x4 rv[2][2][2][2];
#define EPI_LOAD(buf, q) do { const int ai_ = (q) >> 1, m0_ = ((q) & 1) * 2; _Pragma("unroll") for (int mm = 0; mm < 2; ++mm) _Pragma("unroll") for (int bj = 0; bj < 2; ++bj) _Pragma("unroll") for (int n = 0; n < 2; ++n) \
            rv[buf][mm][bj][n] = *(const f32x4*)(R + (size_t)(row0 + ai_ * HALF + (m0_ + mm) * 16) * ldc + col0 + bj * HALF + n * 16); } while (0)
        EPI_LOAD(0, 0);
#pragma unroll
        for (int q = 0; q < 4; ++q) {
            if (q < 3) { if (q & 1) EPI_LOAD(0, q + 1); else EPI_LOAD(1, q + 1); }
            const int ai = q >> 1, m0 = (q & 1) * 2;
#pragma unroll
            for (int mm = 0; mm < 2; ++mm)
#pragma unroll
                for (int bj = 0; bj < 2; ++bj)
#pragma unroll
                    for (int n = 0; n < 2; ++n) *(f32x4*)(C + (size_t)(row0 + ai * HALF + (m0 + mm) * 16) * ldc + col0 + bj * HALF + n * 16) = rv[q & 1][mm][bj][n] + acc[ai][bj][m0 + mm][n];
        }
#undef EPI_LOAD
    }
};

template <class Epi, class Sched>
DI void gemm_phase(LAS unsigned char* lds, const Gemm g, const Sched& S, const Epi& E, int tid) {
    const int wid = __builtin_amdgcn_readfirstlane(tid >> 6), lane = tid & 63, wr = wid >> 2, wc = wid & 3, fr = lane & 15, fq = lane >> 4;
    const int K = g.K, nt = K / BK;
    unsigned voffA[2], voffB[2];
#pragma unroll
    for (int i = 0; i < 2; ++i) { int R, C; stage_rc(tid * 16 + i * 8192, R, C); const int Rb = Epi::PERM ? ((R & ~31) + perm32(R & 31)) : R;
        voffA[i] = (unsigned)(R * g.lda + C) * 2u; voffB[i] = (unsigned)(Rb * g.ldb + C) * 2u; }
    const size_t kstep = (size_t)(BK * 2);
    const size_t hstepA = (size_t)HALF * g.lda * 2, hstepB = (size_t)HALF * g.ldb * 2;
    const size_t tstepA = 2 * hstepA, tstepB = 2 * hstepB;
    const unsigned ldsw = (unsigned)wid * 1024u;
    const int aoff = lds_byte(wr * 64 + fr, fq * 8), boff = lds_byte(wc * 32 + fr, fq * 8);
#define PG8_SA(b, h) (((b) * 2 + (h)) * HTB)
#define PG8_SB(b, h) ((4 + (b) * 2 + (h)) * HTB)
#define PG8_STAGE(bufoff, gbase, voff) do { _Pragma("unroll") for (int _i = 0; _i < 2; ++_i) \
        __builtin_amdgcn_global_load_lds((const unsigned*)((const char*)(gbase) + (voff)[_i]), (LAS unsigned*)(lds + (bufoff) + ldsw + _i * 8192), 16, 0, 0); } while (0)
#define PG8_LDA(dst, b, h) do { _Pragma("unroll") for (int m = 0; m < 4; ++m) _Pragma("unroll") for (int k = 0; k < 2; ++k) dst[m][k] = *(const LAS bf16x8*)(lds + PG8_SA(b, h) + aoff + m * 2048 + k * 1024); } while (0)
#define PG8_LDB(dst, b, h) do { _Pragma("unroll") for (int n = 0; n < 2; ++n) _Pragma("unroll") for (int k = 0; k < 2; ++k) dst[n][k] = *(const LAS bf16x8*)(lds + PG8_SB(b, h) + boff + n * 2048 + k * 1024); } while (0)
#define PG8_MMA(ai, bj, At, Bt) do { __builtin_amdgcn_s_setprio(1); _Pragma("unroll") for (int m = 0; m < 4; ++m) _Pragma("unroll") for (int n = 0; n < 2; ++n) _Pragma("unroll") for (int k = 0; k < 2; ++k) \
        acc[ai][bj][m][n] = __builtin_amdgcn_mfma_f32_16x16x32_bf16(Bt[n][k], At[m][k], acc[ai][bj][m][n], 0, 0, 0); __builtin_amdgcn_s_setprio(0); } while (0)
#define PG8_WAIT_V(n) asm volatile("s_waitcnt vmcnt(" #n ")" ::: "memory")
#define PG8_WAIT_L(n) asm volatile("s_waitcnt lgkmcnt(" #n ")" ::: "memory")
#define PG8_BAR __builtin_amdgcn_s_barrier()
#define PG8_SCHED __builtin_amdgcn_sched_barrier(0)
    Unit cur, nxt; int ui = 0;
    if (!S.next(0, cur)) return;
    f32x4 acc[2][2][4][2];
#pragma unroll
    for (int a = 0; a < 2; ++a)
#pragma unroll
        for (int b = 0; b < 2; ++b)
#pragma unroll
            for (int m = 0; m < 4; ++m)
#pragma unroll
                for (int n = 0; n < 2; ++n) acc[a][b][m][n] = (f32x4){0.f, 0.f, 0.f, 0.f};
    bf16x8 At[4][2], B0[2][2], B1[2][2];
    const char* cA = (const char*)g.A + (size_t)cur.pm * tstepA; const char* cB = (const char*)g.Bt + (size_t)cur.pn * tstepB;
    PG8_STAGE(PG8_SB(0, 0), cB, voffB); PG8_STAGE(PG8_SA(0, 0), cA, voffA); PG8_STAGE(PG8_SB(0, 1), cB + hstepB, voffB); PG8_STAGE(PG8_SA(0, 1), cA + hstepA, voffA);
    if (wr == 1) PG8_BAR;
    PG8_WAIT_V(4); PG8_BAR;
    PG8_STAGE(PG8_SB(1, 0), cB + kstep, voffB); PG8_STAGE(PG8_SA(1, 0), cA + kstep, voffA); PG8_STAGE(PG8_SB(1, 1), cB + hstepB + kstep, voffB);
    PG8_WAIT_V(6); PG8_BAR;
    for (;;) {
        const bool has_next = S.next(ui + 1, nxt);
        const char* nA = has_next ? (const char*)g.A + (size_t)nxt.pm * tstepA : cA; const char* nB = has_next ? (const char*)g.Bt + (size_t)nxt.pn * tstepB : cB;
        for (int t = 0; t < nt; t += 2) {
            const bool last = (t == nt - 2);
            const char* a1 = cA + (size_t)(t + 1) * kstep;
            const char* a2 = last ? nA : cA + (size_t)(t + 2) * kstep; const char* b2 = last ? nB : cB + (size_t)(t + 2) * kstep;
            const char* a3 = a2 + kstep; const char* b3 = b2 + kstep;
            PG8_LDB(B0, 0, 0); PG8_SCHED; PG8_LDA(At, 0, 0); PG8_STAGE(PG8_SA(1, 1), a1 + hstepA, voffA);
            PG8_WAIT_L(8); PG8_BAR; PG8_WAIT_L(0); PG8_MMA(0, 0, At, B0); PG8_BAR; PG8_SCHED;
            PG8_LDB(B1, 0, 1); PG8_STAGE(PG8_SB(0, 0), b2, voffB);
            PG8_BAR; PG8_WAIT_L(0); PG8_MMA(0, 1, At, B1); PG8_BAR;
            PG8_LDA(At, 0, 1); PG8_STAGE(PG8_SA(0, 0), a2, voffA);
            PG8_BAR; PG8_WAIT_L(0); PG8_MMA(1, 0, At, B0); PG8_BAR; PG8_SCHED;
            PG8_STAGE(PG8_SB(0, 1), b2 + hstepB, voffB);
            PG8_WAIT_V(6); PG8_BAR; PG8_MMA(1, 1, At, B1); PG8_BAR;
            PG8_LDB(B0, 1, 0); PG8_SCHED; PG8_LDA(At, 1, 0); PG8_STAGE(PG8_SA(0, 1), a2 + hstepA, voffA);
            PG8_WAIT_L(8); PG8_BAR; PG8_WAIT_L(0); PG8_MMA(0, 0, At, B0); PG8_BAR; PG8_SCHED;
            PG8_LDB(B1, 1, 1); PG8_STAGE(PG8_SB(1, 0), b3, voffB);
            PG8_BAR; PG8_WAIT_L(0); PG8_MMA(0, 1, At, B1); PG8_BAR;
            PG8_LDA(At, 1, 1); PG8_STAGE(PG8_SA(1, 0), a3, voffA);
            PG8_BAR; PG8_WAIT_L(0); PG8_MMA(1, 0, At, B0); PG8_BAR; PG8_SCHED;
            PG8_STAGE(PG8_SB(1, 1), b3 + hstepB, voffB);
            PG8_WAIT_V(6); PG8_BAR; PG8_MMA(1, 1, At, B1); PG8_BAR;
        }
        E(acc, cur, wr, wc, fr, fq);
        if (!has_next) break;
#pragma unroll
        for (int a = 0; a < 2; ++a)
#pragma unroll
            for (int b = 0; b < 2; ++b)
#pragma unroll
                for (int m = 0; m < 4; ++m)
#pragma unroll
                    for (int n = 0; n < 2; ++n) acc[a][b][m][n] = (f32x4){0.f, 0.f, 0.f, 0.f};
        cur = nxt; cA = nA; cB = nB; ++ui;
    }
    PG8_WAIT_V(0);
    if (wr == 0) PG8_BAR;
    PG8_BAR;
#undef PG8_SA
#undef PG8_SB
#undef PG8_STAGE
#undef PG8_LDA
#undef PG8_LDB
#undef PG8_MMA
#undef PG8_WAIT_V
#undef PG8_WAIT_L
#undef PG8_BAR
#undef PG8_SCHED
}
}


struct Params {
    const float *x, *e_norm_w, *e_w_in, *e_conv_w, *e_conv_b, *e_dt_bias, *e_a_log, *e_d_skip, *e_ssd_norm_w, *e_q_norm, *e_k_norm, *e_w_out;
    const float *o_norm_w, *o_w_in, *o_q_norm, *o_k_norm, *o_w_out;
    float* out; unsigned char* ws;
};
#define LDS_WAIT() asm volatile("s_waitcnt lgkmcnt(0)" ::: "memory")

DI void transpose_item(const float* W, int Ns, int K, bf16_t* WT, int n0, int sc0, int k0, const float* scale, float* scr, int lane) {
    float wv[32];
#pragma unroll
    for (int i = 0; i < 32; ++i) { const int kk = 2 * i + (lane >> 5); wv[i] = W[(size_t)(k0 + kk) * Ns + sc0 + (lane & 31)]; }
#pragma unroll
    for (int i = 0; i < 32; ++i) { const int kk = 2 * i + (lane >> 5); const float sc = scale ? scale[k0 + kk] : 1.f; scr[kk * 33 + (lane & 31)] = wv[i] * sc; }
    LDS_WAIT();
    const int c = lane & 7;
#pragma unroll
    for (int j = 0; j < 4; ++j) { const int n = (lane >> 3) + 8 * j; const float* s = scr + (8 * c) * 33 + n;
        u32x4 o; o.x = pk2(s[0 * 33], s[1 * 33]); o.y = pk2(s[2 * 33], s[3 * 33]); o.z = pk2(s[4 * 33], s[5 * 33]); o.w = pk2(s[6 * 33], s[7 * 33]);
        *(u32x4*)(WT + (size_t)(n0 + n) * K + k0 + 8 * c) = o; }
    LDS_WAIT();
}

template <bool WITH_DT>
DI void rows_phase(const float* src, bf16_t* xb, float* rstd_out, float* dtraw, const f32x4* wl, int gw, int NGW, int lane) {
    for (int row = gw; row < T; row += NGW) {
        const f32x4* xr = (const f32x4*)(src + (size_t)row * D) + lane;
        f32x4 v[4]; float ss = 0.f;
#pragma unroll
        for (int j = 0; j < 4; ++j) { v[j] = xr[64 * j]; ss += (v[j].x * v[j].x + v[j].y * v[j].y) + (v[j].z * v[j].z + v[j].w * v[j].w); }
        const float rstd = rsqrtf(wave_sum(ss) * (1.f / D) + EPS);
        u32x2* o8 = (u32x2*)(xb + (size_t)row * D) + lane;
#pragma unroll
        for (int j = 0; j < 4; ++j) { u32x2 w; w.x = pk2(v[j].x, v[j].y); w.y = pk2(v[j].z, v[j].w); o8[64 * j] = w; }
        if (lane == 0) rstd_out[row] = rstd;
        if (WITH_DT) {
            f32x4 acc[4];
#pragma unroll
            for (int c = 0; c < 4; ++c) acc[c] = (f32x4){0.f, 0.f, 0.f, 0.f};
#pragma unroll
            for (int j = 0; j < 4; ++j)
#pragma unroll
                for (int t = 0; t < 4; ++t) { const float xv = v[j][t];
#pragma unroll
                    for (int c = 0; c < 4; ++c) acc[c] += wl[((j * 4 + t) * 4 + c) * 64 + lane] * xv; }
            float a[16];
#pragma unroll
            for (int c = 0; c < 4; ++c)
#pragma unroll
                for (int t = 0; t < 4; ++t) a[c * 4 + t] = acc[c][t];
#pragma unroll
            for (int i = 0; i < 8; ++i) { const bool up = (lane & 32) != 0; const float keep = up ? a[i + 8] : a[i], send = up ? a[i] : a[i + 8]; a[i] = keep + __shfl_xor(send, 32); }
#pragma unroll
            for (int i = 0; i < 4; ++i) { const bool up = (lane & 16) != 0; const float keep = up ? a[i + 4] : a[i], send = up ? a[i] : a[i + 4]; a[i] = keep + __shfl_xor(send, 16); }
#pragma unroll
            for (int i = 0; i < 2; ++i) { const bool up = (lane & 8) != 0; const float keep = up ? a[i + 2] : a[i], send = up ? a[i] : a[i + 2]; a[i] = keep + __shfl_xor(send, 8); }
            { const bool up = (lane & 4) != 0; const float keep = up ? a[1] : a[0], send = up ? a[0] : a[1]; a[0] = keep + __shfl_xor(send, 4); }
            a[0] += __shfl_xor(a[0], 2); a[0] += __shfl_xor(a[0], 1);
            if ((lane & 3) == 0) dtraw[(size_t)row * 16 + (lane >> 2)] = a[0] * rstd;
        }
    }
}

DI void qk_norm_rope_item(bf16_t* base, int ld, int row0, int nsub, int col, const float* w, float qscale, const float* rope, float* kmean_out, int lane) {
    const int c = lane & 7, rs = lane >> 3;
    float wv[8], msum[8];
#pragma unroll
    for (int j = 0; j < 8; ++j) { wv[j] = w[8 * c + j] * qscale; msum[j] = 0.f; }
    for (int sub = 0; sub < nsub; ++sub) {
        u32x4 raw[4]; f32x4 rpv[4][4];
#pragma unroll
        for (int ps = 0; ps < 4; ++ps) { raw[ps] = *(const u32x4*)(base + (size_t)(row0 + sub * 32 + ps * 8 + rs) * ld + col + 8 * c);
            const f32x4* rp = (const f32x4*)(rope + ((row0 + sub * 32 + ps * 8 + rs) & (SEQ - 1)) * 16);
#pragma unroll
            for (int j = 0; j < 4; ++j) rpv[ps][j] = (c < 2) ? rp[j] : (f32x4){0.f, 0.f, 0.f, 0.f}; }
#pragma unroll
        for (int ps = 0; ps < 4; ++ps) {
            const int row = row0 + sub * 32 + ps * 8 + rs, pos = row & (SEQ - 1);
            float v[8] = {bflo(raw[ps].x), bfhi(raw[ps].x), bflo(raw[ps].y), bfhi(raw[ps].y), bflo(raw[ps].z), bfhi(raw[ps].z), bflo(raw[ps].w), bfhi(raw[ps].w)};
            float ss = 0.f;
#pragma unroll
            for (int j = 0; j < 8; ++j) ss += v[j] * v[j];
            ss += __shfl_xor(ss, 1); ss += __shfl_xor(ss, 2); ss += __shfl_xor(ss, 4);
            const float r = rsqrtf(ss * (1.f / 64.f) + EPS);
#pragma unroll
            for (int j = 0; j < 8; ++j) v[j] *= r * wv[j];
            float o[8];
#pragma unroll
            for (int j = 0; j < 8; ++j) o[j] = __shfl_xor(v[j], 1);
            if (c < 2) {
                const f32x4 c0 = rpv[ps][0], c1 = rpv[ps][1], s0 = rpv[ps][2], s1 = rpv[ps][3];
                const float cs[8] = {c0.x, c0.y, c0.z, c0.w, c1.x, c1.y, c1.z, c1.w}, sn[8] = {s0.x, s0.y, s0.z, s0.w, s1.x, s1.y, s1.z, s1.w};
#pragma unroll
                for (int j = 0; j < 8; ++j) v[j] = (c == 0) ? (v[j] * cs[j] - o[j] * sn[j]) : (v[j] * cs[j] + o[j] * sn[j]);
            }
            u32x4 w4; w4.x = pk2(v[0], v[1]); w4.y = pk2(v[2], v[3]); w4.z = pk2(v[4], v[5]); w4.w = pk2(v[6], v[7]);
            *(u32x4*)(base + (size_t)row * ld + col + 8 * c) = w4;
#pragma unroll
            for (int j = 0; j < 8; ++j) msum[j] += v[j];
        }
    }
    if (kmean_out) {
#pragma unroll
        for (int j = 0; j < 8; ++j) { float s = msum[j]; s += __shfl_xor(s, 8); s += __shfl_xor(s, 16); s += __shfl_xor(s, 32); if (rs == 0) kmean_out[8 * c + j] = s; }
    }
}

DI void conv_item(const bf16_t* proj, bf16_t* conv, const float* cw, const float* cb, int row0, int ch0, int lane) {
    const int ch = ch0 + lane * 8;
    u32x4 rr[19];
    const bool head = (row0 & (SEQ - 1)) == 0;
#pragma unroll
    for (int t = 0; t < 19; ++t) { if (t >= 3 || !head) rr[t] = *(const u32x4*)(proj + (size_t)(row0 + t - 3) * N0 + XBC_OFF + ch); else rr[t] = (u32x4){0u, 0u, 0u, 0u}; }
    float w0[8], w1[8], w2[8], w3[8], b[8];
#pragma unroll
    for (int j = 0; j < 8; ++j) { const f32x4 ww = *(const f32x4*)(cw + (size_t)(ch + j) * 4); w0[j] = ww.x; w1[j] = ww.y; w2[j] = ww.z; w3[j] = ww.w; b[j] = cb[ch + j]; }
#pragma unroll
    for (int t = 0; t < 16; ++t) {
        const u32x4 a = rr[t], bq = rr[t + 1], c = rr[t + 2], d = rr[t + 3];
        const float x0[8] = {bflo(a.x), bfhi(a.x), bflo(a.y), bfhi(a.y), bflo(a.z), bfhi(a.z), bflo(a.w), bfhi(a.w)};
        const float x1[8] = {bflo(bq.x), bfhi(bq.x), bflo(bq.y), bfhi(bq.y), bflo(bq.z), bfhi(bq.z), bflo(bq.w), bfhi(bq.w)};
        const float x2[8] = {bflo(c.x), bfhi(c.x), bflo(c.y), bfhi(c.y), bflo(c.z), bfhi(c.z), bflo(c.w), bfhi(c.w)};
        const float x3[8] = {bflo(d.x), bfhi(d.x), bflo(d.y), bfhi(d.y), bflo(d.z), bfhi(d.z), bflo(d.w), bfhi(d.w)};
        float y[8];
#pragma unroll
        for (int j = 0; j < 8; ++j) y[j] = silu_f(b[j] + w0[j] * x0[j] + w1[j] * x1[j] + w2[j] * x2[j] + w3[j] * x3[j]);
        u32x4 o; o.x = pk2(y[0], y[1]); o.y = pk2(y[2], y[3]); o.z = pk2(y[4], y[5]); o.w = pk2(y[6], y[7]);
        *(u32x4*)(conv + (size_t)(row0 + t) * 2048 + ch) = o;
    }
}

DI void dt_item(const float* dtraw, float* dt_out, float* acs_out, const float* dt_bias, const float* a_log, int item, int lane) {
    const int h = item & 15, row0 = (item >> 4) * 256;
    const float bias = dt_bias[h], A = -expf(a_log[h]);
    float d[4], a[4];
#pragma unroll
    for (int t = 0; t < 4; ++t) d[t] = dtraw[(size_t)(row0 + 4 * lane + t) * 16 + h];
#pragma unroll
    for (int t = 0; t < 4; ++t) { const float v = d[t] + bias; d[t] = fmaxf(v, 0.f) + log1pf(expf(-fabsf(v))); a[t] = d[t] * A; }
    a[1] += a[0]; a[2] += a[1]; a[3] += a[2];
    float tot = a[3];
#pragma unroll
    for (int o = 1; o < 64; o <<= 1) { const float n = __shfl_up(tot, o); if (lane >= o) tot += n; }
    const float excl = tot - a[3];
#pragma unroll
    for (int t = 0; t < 4; ++t) { const size_t idx = (size_t)(row0 + 4 * lane + t) * 16 + h; dt_out[idx] = d[t]; acs_out[idx] = a[t] + excl; }
}

DI void softmax_fs2(f32x16& sa, f32x16& sb, float& l, f32x16& o0, f32x16& o1, const unsigned char* Vs, int vrow0, int lane, float shl) {
    const int hh = lane >> 5, q = (lane & 15) >> 2, p = lane & 3, blk = (lane >> 4) & 1;
    float ls0 = 0.f, ls1 = 0.f;
#pragma unroll
    for (int i = 0; i < 16; ++i) { const float pa = ex2(__builtin_fmaf(sa[i], LOG2E, -shl)), pb = ex2(__builtin_fmaf(sb[i], LOG2E, -shl)); sa[i] = pa; sb[i] = pb; ls0 += pa; ls1 += pb; }
    l += ls0 + ls1;
    const unsigned char* vb = Vs + (size_t)(vrow0 + 4 * hh + q) * 144 + 32 * blk + 8 * p;
#pragma unroll
    for (int sp = 0; sp < 2; ++sp) {
        const bf16x8 pfa = pack8(sa, sp), pfb = pack8(sb, sp);
        const unsigned char* va = vb + (size_t)(16 * sp) * 144; const unsigned char* vc = va + 32 * 144;
        o0 = MFMA32(cat8(tr_read(va), tr_read(va + 8 * 144)), pfa, o0);
        o1 = MFMA32(cat8(tr_read(va + 64), tr_read(va + 8 * 144 + 64)), pfa, o1);
        o0 = MFMA32(cat8(tr_read(vc), tr_read(vc + 8 * 144)), pfb, o0);
        o1 = MFMA32(cat8(tr_read(vc + 64), tr_read(vc + 8 * 144 + 64)), pfb, o1);
    }
}
DI void softmax_fs1(f32x16& s, float& l, f32x16& o0, f32x16& o1, const unsigned char* Vs, int vrow0, int lane, float shl) {
    const int hh = lane >> 5, q = (lane & 15) >> 2, p = lane & 3, blk = (lane >> 4) & 1;
    float ls = 0.f;
#pragma unroll
    for (int i = 0; i < 16; ++i) { const float pe = ex2(__builtin_fmaf(s[i], LOG2E, -shl)); s[i] = pe; ls += pe; }
    l += ls;
#pragma unroll
    for (int sp = 0; sp < 2; ++sp) {
        const bf16x8 pf = pack8(s, sp);
        const unsigned char* vb = Vs + (size_t)(vrow0 + 16 * sp + 4 * hh + q) * 144 + 32 * blk + 8 * p;
        o0 = MFMA32(cat8(tr_read(vb), tr_read(vb + 8 * 144)), pf, o0);
        o1 = MFMA32(cat8(tr_read(vb + 64), tr_read(vb + 8 * 144 + 64)), pf, o1);
    }
}
DI float score_bound(const float* qnw, const float* knw, int lane) {
    float a = fabsf(qnw[lane]), b = fabsf(knw[lane]);
#pragma unroll
    for (int o = 1; o < 64; o <<= 1) { a = fmaxf(a, __shfl_xor(a, o)); b = fmaxf(b, __shfl_xor(b, o)); }
    return 8.f * a * b;
}
DI void softmax_exp2t(const f32x16& sa, const f32x16& sb, float& l, bf16x8 (&pf)[4], float shl) {
    f32x16 pa, pb; float ls0 = 0.f, ls1 = 0.f;
#pragma unroll
    for (int i = 0; i < 16; ++i) { pa[i] = ex2(__builtin_fmaf(sa[i], LOG2E, -shl)); pb[i] = ex2(__builtin_fmaf(sb[i], LOG2E, -shl)); ls0 += pa[i]; ls1 += pb[i]; }
    l += ls0 + ls1;
    pf[0] = pack8(pa, 0); pf[1] = pack8(pa, 1); pf[2] = pack8(pb, 0); pf[3] = pack8(pb, 1);
}
DI void pv_mfma2t(const bf16x8 (&pf)[4], f32x16& o0, f32x16& o1, const unsigned char* Vs, int vrow0, int lane) {
    const int hh = lane >> 5, q = (lane & 15) >> 2, p = lane & 3, blk = (lane >> 4) & 1;
    const unsigned char* vb = Vs + (size_t)(vrow0 + 4 * hh + q) * 144 + 32 * blk + 8 * p;
#pragma unroll
    for (int sp = 0; sp < 2; ++sp) {
        const unsigned char* va = vb + (size_t)(16 * sp) * 144; const unsigned char* vc = va + 32 * 144;
        o0 = MFMA32(cat8(tr_read(va), tr_read(va + 8 * 144)), pf[sp], o0);
        o1 = MFMA32(cat8(tr_read(va + 64), tr_read(va + 8 * 144 + 64)), pf[sp], o1);
        o0 = MFMA32(cat8(tr_read(vc), tr_read(vc + 8 * 144)), pf[2 + sp], o0);
        o1 = MFMA32(cat8(tr_read(vc + 64), tr_read(vc + 8 * 144 + 64)), pf[2 + sp], o1);
    }
}
#define SCHED_MIX(n) do { _Pragma("unroll") for (int i_ = 0; i_ < (n); ++i_) { __builtin_amdgcn_sched_group_barrier(0x008, 1, 0); __builtin_amdgcn_sched_group_barrier(0x100, 2, 0); __builtin_amdgcn_sched_group_barrier(0x002, 6, 0); } } while (0)
DI f32x16 qk_tile(const unsigned char* Ks, int kt, const bf16x8 (&qf)[4], int lane) {
    const int r = lane & 31, hh = lane >> 5;
    const unsigned char* kp = Ks + (size_t)(kt + r) * 144 + 16 * hh;
    f32x16 s = zero16();
#pragma unroll
    for (int kk = 0; kk < 4; ++kk) s = MFMA32(*(const bf16x8*)(kp + 32 * kk), qf[kk], s);
    return s;
}
DI void mask_le(f32x16& s, int lane) { const int r = lane & 31, hh = lane >> 5;
#pragma unroll
    for (int i = 0; i < 16; ++i) s[i] = (crow(i, hh) <= r) ? s[i] : -1e30f; }
DI void mask_ge(f32x16& s, int lane) { const int r = lane & 31, hh = lane >> 5;
#pragma unroll
    for (int i = 0; i < 16; ++i) s[i] = (crow(i, hh) >= r) ? s[i] : -1e30f; }

DI void dil_attn_item(unsigned char* lds, const bf16_t* proj, bf16_t* og, float* lse, const float* qnw, const float* knw, const float* rope, int item, int tid, int wave, int lane) {
    const int gi = item >> 8, within = item & 255, dsh = 2 * gi, dil = 1 << dsh;
    const int tps = 16 >> dsh, seq = within / tps, tile = within % tps;
    const int res = seq & (dil - 1), bs = seq >> dsh, slot = bs & 7, bl = bs >> 3;
    const int u0 = tile * 256, head = gi * 8 + slot, rowbase = bl * SEQ + res;
    const int r = lane & 31, hh = lane >> 5;
    unsigned char* Ks = lds; unsigned char* Vs = lds + 384 * 144;
    {
        const int ck = tid & 7;
        float wk[8];
#pragma unroll
        for (int j = 0; j < 8; ++j) wk[j] = knw[8 * ck + j];
        {
        u32x4 kr[6], vr[6]; f32x4 rpv[6][4];
#pragma unroll
        for (int i = 0; i < 6; ++i) { const int ki = (tid >> 3) + 64 * i, u = u0 - 128 + ki;
            if (u >= 0) { const bf16_t* src = proj + (size_t)(rowbase + u * dil) * N0 + head * 64 + ck * 8; kr[i] = *(const u32x4*)(src + K_OFF); vr[i] = *(const u32x4*)(src + V_OFF);
                const f32x4* rp = (const f32x4*)(rope + (u * dil + res) * 16);
#pragma unroll
                for (int j = 0; j < 4; ++j) rpv[i][j] = rp[j]; } }
#pragma unroll
        for (int i = 0; i < 6; ++i) { const int ki = (tid >> 3) + 64 * i, u = u0 - 128 + ki;
            if (u >= 0) {
                float v[8] = {bflo(kr[i].x), bfhi(kr[i].x), bflo(kr[i].y), bfhi(kr[i].y), bflo(kr[i].z), bfhi(kr[i].z), bflo(kr[i].w), bfhi(kr[i].w)};
                float ss = 0.f;
#pragma unroll
                for (int j = 0; j < 8; ++j) ss += v[j] * v[j];
                ss += __shfl_xor(ss, 1); ss += __shfl_xor(ss, 2); ss += __shfl_xor(ss, 4);
                const float rn = rsqrtf(ss * (1.f / 64.f) + EPS);
#pragma unroll
                for (int j = 0; j < 8; ++j) v[j] *= rn * wk[j];
                float o[8];
#pragma unroll
                for (int j = 0; j < 8; ++j) o[j] = __shfl_xor(v[j], 1);
                if (ck < 2) {
                    const f32x4 c0 = rpv[i][0], c1 = rpv[i][1], s0 = rpv[i][2], s1 = rpv[i][3];
                    const float cs[8] = {c0.x, c0.y, c0.z, c0.w, c1.x, c1.y, c1.z, c1.w}, sn[8] = {s0.x, s0.y, s0.z, s0.w, s1.x, s1.y, s1.z, s1.w};
#pragma unroll
                    for (int j = 0; j < 8; ++j) v[j] = (ck == 0) ? (v[j] * cs[j] - o[j] * sn[j]) : (v[j] * cs[j] + o[j] * sn[j]);
                }
                u32x4 w4; w4.x = pk2(v[0], v[1]); w4.y = pk2(v[2], v[3]); w4.z = pk2(v[4], v[5]); w4.w = pk2(v[6], v[7]);
                *(u32x4*)(Ks + ki * 144 + ck * 16) = w4; *(u32x4*)(Vs + ki * 144 + ck * 16) = vr[i];
            } }
        }
    }
    const int upos = u0 + 32 * wave + r, qrow = rowbase + upos * dil;
    bf16x8 qf[4];
    {
        u32x4 qr[4]; f32x4 qw0[4], qw1[4];
#pragma unroll
        for (int kk = 0; kk < 4; ++kk) { qr[kk] = *(const u32x4*)(proj + (size_t)qrow * N0 + Q_OFF + head * 64 + 16 * kk + 8 * hh);
            qw0[kk] = *(const f32x4*)(qnw + 16 * kk + 8 * hh); qw1[kk] = *(const f32x4*)(qnw + 16 * kk + 8 * hh + 4); }
        float qv[4][8]; float ss = 0.f;
#pragma unroll
        for (int kk = 0; kk < 4; ++kk) { qv[kk][0] = bflo(qr[kk].x); qv[kk][1] = bfhi(qr[kk].x); qv[kk][2] = bflo(qr[kk].y); qv[kk][3] = bfhi(qr[kk].y); qv[kk][4] = bflo(qr[kk].z); qv[kk][5] = bfhi(qr[kk].z); qv[kk][6] = bflo(qr[kk].w); qv[kk][7] = bfhi(qr[kk].w);
#pragma unroll
            for (int j = 0; j < 8; ++j) ss += qv[kk][j] * qv[kk][j]; }
        ss += __shfl_xor(ss, 32);
        const float rn = rsqrtf(ss * (1.f / 64.f) + EPS) * 0.125f;
#pragma unroll
        for (int kk = 0; kk < 4; ++kk) { const f32x4 w0 = qw0[kk], w1 = qw1[kk];
            qv[kk][0] *= rn * w0.x; qv[kk][1] *= rn * w0.y; qv[kk][2] *= rn * w0.z; qv[kk][3] *= rn * w0.w; qv[kk][4] *= rn * w1.x; qv[kk][5] *= rn * w1.y; qv[kk][6] *= rn * w1.z; qv[kk][7] *= rn * w1.w; }
        {
            const f32x4* rp = (const f32x4*)(rope + (upos * dil + res) * 16);
            const f32x4 c0 = rp[0], c1 = rp[1], s0 = rp[2], s1 = rp[3];
            const float cs[8] = {c0.x, c0.y, c0.z, c0.w, c1.x, c1.y, c1.z, c1.w}, sn[8] = {s0.x, s0.y, s0.z, s0.w, s1.x, s1.y, s1.z, s1.w};
#pragma unroll
            for (int j = 0; j < 8; ++j) { const float o = __shfl_xor(qv[0][j], 32); qv[0][j] = (hh == 0) ? (qv[0][j] * cs[j] - o * sn[j]) : (qv[0][j] * cs[j] + o * sn[j]); }
        }
#pragma unroll
        for (int kk = 0; kk < 4; ++kk) { u32x4 w4; w4.x = pk2(qv[kk][0], qv[kk][1]); w4.y = pk2(qv[kk][2], qv[kk][3]); w4.z = pk2(qv[kk][4], qv[kk][5]); w4.w = pk2(qv[kk][6], qv[kk][7]); qf[kk] = __builtin_bit_cast(bf16x8, w4); }
    }
    __syncthreads();
    const float smax = score_bound(qnw, knw, lane), shl = smax * LOG2E;
    float l = 0.f; f32x16 o0 = zero16(), o1 = zero16();
    const int tb = (u0 == 0) ? (wave < 4 ? 4 - wave : 0) : 0;
    for (int t = tb; t < 5;) {
        const int kt = 32 * (wave + t);
        if (t + 1 < 5) {
            f32x16 sa = qk_tile(Ks, kt, qf, lane), sb = qk_tile(Ks, kt + 32, qf, lane);
            if (t == 0) mask_ge(sa, lane);
            if (t + 1 == 4) mask_le(sb, lane);
            softmax_fs2(sa, sb, l, o0, o1, Vs, kt, lane, shl);
            t += 2;
        } else {
            f32x16 s = qk_tile(Ks, kt, qf, lane);
            mask_le(s, lane);
            softmax_fs1(s, l, o0, o1, Vs, kt, lane, shl);
            t += 1;
        }
    }
    l += __shfl_xor(l, 32);
    const float inv = 1.f / l;
    bf16_t* orow = og + ((size_t)gi * TS + qrow) * 512 + slot * 64;
#pragma unroll
    for (int ig = 0; ig < 4; ++ig) {
        u32x2 w; w.x = pk2(o0[4 * ig] * inv, o0[4 * ig + 1] * inv); w.y = pk2(o0[4 * ig + 2] * inv, o0[4 * ig + 3] * inv); *(u32x2*)(orow + 8 * ig + 4 * hh) = w;
        w.x = pk2(o1[4 * ig] * inv, o1[4 * ig + 1] * inv); w.y = pk2(o1[4 * ig + 2] * inv, o1[4 * ig + 3] * inv); *(u32x2*)(orow + 32 + 8 * ig + 4 * hh) = w;
    }
    if (hh == 0) lse[((size_t)gi * TS + qrow) * 8 + slot] = smax + logf(l);
    __syncthreads();
}

DI void ssd_intra_item(unsigned char* lds, bf16_t* conv, const float* dt, const float* acs, float* states, const float* d_skip, int item, int tid, int wave, int lane) {
    const int h = item & 15, bc = item >> 4, g = h >> 2, row0 = bc * 256;
    const int r = lane & 31, hh = lane >> 5, q = (lane & 15) >> 2, p = lane & 3, blk = (lane >> 4) & 1;
    unsigned char* Bs = lds; unsigned char* Xs = lds + 256 * 272; float* acs_s = (float*)(lds + 256 * 272 + 256 * 144);
    if (tid < 256) acs_s[tid] = acs[(size_t)(row0 + tid) * 16 + h];
#pragma unroll
    for (int i = 0; i < 8; ++i) { const int e = tid + 512 * i, row = e >> 4, ck = e & 15;
        *(u32x4*)(Bs + row * 272 + ck * 16) = *(const u32x4*)(conv + (size_t)(row0 + row) * 2048 + 1024 + g * 128 + ck * 8); }
#pragma unroll
    for (int i = 0; i < 4; ++i) { const int e = tid + 512 * i, row = e >> 3, ck = e & 7;
        const u32x4 raw = *(const u32x4*)(conv + (size_t)(row0 + row) * 2048 + h * 64 + ck * 8); const float dv = dt[(size_t)(row0 + row) * 16 + h];
        u32x4 w; w.x = pk2(bflo(raw.x) * dv, bfhi(raw.x) * dv); w.y = pk2(bflo(raw.y) * dv, bfhi(raw.y) * dv); w.z = pk2(bflo(raw.z) * dv, bfhi(raw.z) * dv); w.w = pk2(bflo(raw.w) * dv, bfhi(raw.w) * dv);
        *(u32x4*)(Xs + row * 144 + ck * 16) = w; }
    const int l0 = 32 * wave;
    bf16x8 cf[8];
#pragma unroll
    for (int kk = 0; kk < 8; ++kk) cf[kk] = *(const bf16x8*)(conv + (size_t)(row0 + l0 + r) * 2048 + 1536 + g * 128 + 16 * kk + 8 * hh);
    __syncthreads();
    const float acl = acs_s[l0 + r] * LOG2E;
    f32x16 y0 = zero16(), y1 = zero16();
    for (int st = 0; st <= wave; ++st) {
        const int s0 = 32 * st;
        f32x16 x = zero16();
#pragma unroll
        for (int kk = 0; kk < 8; ++kk) { const bf16x8 a = *(const bf16x8*)(Bs + (s0 + r) * 272 + (16 * kk + 8 * hh) * 2); x = MFMA32(a, cf[kk], x); }
        const bool diag = (st == wave);
#pragma unroll
        for (int g4 = 0; g4 < 4; ++g4) { const f32x4 as4 = *(const f32x4*)(acs_s + s0 + 8 * g4 + 4 * hh);
#pragma unroll
            for (int j = 0; j < 4; ++j) { const int i = 4 * g4 + j, sl = 8 * g4 + 4 * hh + j; const float dec = ex2(__builtin_fmaf(as4[j], -LOG2E, acl)); const float v = x[i] * dec; x[i] = (diag && sl > r) ? 0.f : v; } }
#pragma unroll
        for (int sp = 0; sp < 2; ++sp) {
            const bf16x8 pf = pack8(x, sp);
            const unsigned char* vb = Xs + (size_t)(s0 + 16 * sp + 4 * hh + q) * 144 + 32 * blk + 8 * p;
            y0 = MFMA32(cat8(tr_read(vb), tr_read(vb + 8 * 144)), pf, y0);
            y1 = MFMA32(cat8(tr_read(vb + 64), tr_read(vb + 8 * 144 + 64)), pf, y1);
        }
    }
    {
        const float Dk = d_skip[h];
        bf16_t* xrow = conv + (size_t)(row0 + l0 + r) * 2048 + h * 64;
        u32x2 xa[4], xb2[4];
#pragma unroll
        for (int ig = 0; ig < 4; ++ig) { xa[ig] = *(const u32x2*)(xrow + 8 * ig + 4 * hh); xb2[ig] = *(const u32x2*)(xrow + 32 + 8 * ig + 4 * hh); }
#pragma unroll
        for (int ig = 0; ig < 4; ++ig) {
            const u32x2 a = xa[ig], b = xb2[ig]; u32x2 w;
            w.x = pk2(y0[4 * ig] + Dk * bflo(a.x), y0[4 * ig + 1] + Dk * bfhi(a.x)); w.y = pk2(y0[4 * ig + 2] + Dk * bflo(a.y), y0[4 * ig + 3] + Dk * bfhi(a.y)); *(u32x2*)(xrow + 8 * ig + 4 * hh) = w;
            w.x = pk2(y1[4 * ig] + Dk * bflo(b.x), y1[4 * ig + 1] + Dk * bfhi(b.x)); w.y = pk2(y1[4 * ig + 2] + Dk * bflo(b.y), y1[4 * ig + 3] + Dk * bfhi(b.y)); *(u32x2*)(xrow + 32 + 8 * ig + 4 * hh) = w;
        }
    }
    __syncthreads();
    {
        const float last = acs_s[255];
#pragma unroll
        for (int i = 0; i < 4; ++i) { const int e = tid + 512 * i, row = e >> 3, ck = e & 7; u32x4* pp = (u32x4*)(Xs + row * 144 + ck * 16);
            const u32x4 raw = *pp; const float dv = ex2((last - acs_s[row]) * LOG2E);
            u32x4 w; w.x = pk2(bflo(raw.x) * dv, bfhi(raw.x) * dv); w.y = pk2(bflo(raw.y) * dv, bfhi(raw.y) * dv); w.z = pk2(bflo(raw.z) * dv, bfhi(raw.z) * dv); w.w = pk2(bflo(raw.w) * dv, bfhi(raw.w) * dv);
            *pp = w; }
    }
    __syncthreads();
    {
        const int pb = wave & 1, nb = wave >> 1;
        f32x16 sa = zero16(), sa2 = zero16();
#pragma unroll 4
        for (int ks = 0; ks < 16; ks += 2) {
            const int rl = 16 * ks + 8 * hh + q;
            const unsigned char* xa = Xs + (size_t)rl * 144 + (32 * pb + 16 * blk) * 2 + 8 * p;
            const unsigned char* ba = Bs + (size_t)rl * 272 + (32 * nb + 16 * blk) * 2 + 8 * p;
            sa = MFMA32(cat8(tr_read(xa), tr_read(xa + 4 * 144)), cat8(tr_read(ba), tr_read(ba + 4 * 272)), sa);
            sa2 = MFMA32(cat8(tr_read(xa + 16 * 144), tr_read(xa + 20 * 144)), cat8(tr_read(ba + 16 * 272), tr_read(ba + 20 * 272)), sa2);
        }
        sa += sa2;
        float* so = states + (size_t)(bc * 16 + h) * 8192 + 32 * nb + r;
#pragma unroll
        for (int i = 0; i < 16; ++i) so[(32 * pb + crow(i, hh)) * 128] = sa[i];
    }
    __syncthreads();
}

DI void ssd_final_item(unsigned char* lds, const bf16_t* conv, const bf16_t* proj, bf16_t* mixed, const float* acs, const float* states, const float* normw, int item, int tid, int wave, int lane) {
    const int g = item & 3, h2 = (item >> 2) & 1, bc = item >> 3, c = bc & 15, bl = bc >> 4, row0 = bc * 256 + 128 * h2;
    const int r = lane & 31, hh = lane >> 5, grp = wave >> 2, lt = wave & 3, gt = tid & 255;
    unsigned char* Zs = lds + 4 * 17408 + grp * (2 * 128 * 144); unsigned char* Ys = Zs + 128 * 144;
    float* ssx = (float*)(lds + 4 * 17408 + 4 * 128 * 144);
    float* nws = ssx + 256;
    if (tid < 64) ((f32x4*)nws)[tid] = ((const f32x4*)(normw + g * 256))[tid];
    const int srow = gt >> 3, sck = gt & 7;
    u32x4 zr[4], yr[4];
#pragma unroll
    for (int i = 0; i < 4; ++i) { zr[i] = *(const u32x4*)(proj + (size_t)(row0 + srow + 32 * i) * N0 + Z_OFF + (g * 4 + 2 * grp) * 64 + sck * 8); yr[i] = *(const u32x4*)(conv + (size_t)(row0 + srow + 32 * i) * 2048 + (g * 4 + 2 * grp) * 64 + sck * 8); }
    {
        const float* sb = states + (size_t)((bl * 16 + c) * 16 + g * 4) * 8192;
        f32x4 ev[16];
#pragma unroll
        for (int i = 0; i < 16; ++i) ev[i] = (c > 0) ? *(const f32x4*)(sb + (size_t)(i >> 2) * 8192 + (size_t)((tid + 512 * i) & 2047) * 4) : (f32x4){0.f, 0.f, 0.f, 0.f};
#pragma unroll
        for (int i = 0; i < 16; ++i) { const int idx = (tid + 512 * i) & 2047, pp = idx >> 5, n4 = idx & 31;
            u32x2 w; w.x = pk2(ev[i].x, ev[i].y); w.y = pk2(ev[i].z, ev[i].w);
            *(u32x2*)(lds + (i >> 2) * 17408 + pp * 272 + n4 * 8) = w; }
    }
    const int lr = 32 * lt + r, lrow = row0 + lr;
    bf16x8 cf[8];
#pragma unroll
    for (int kk = 0; kk < 8; ++kk) cf[kk] = *(const bf16x8*)(conv + (size_t)lrow * 2048 + 1536 + g * 128 + 16 * kk + 8 * hh);
    unsigned ypx[2][2][4], ypy[2][2][4]; float ss = 0.f;
#pragma unroll
    for (int j = 0; j < 2; ++j) {
        const int hd = 2 * grp + j;
#pragma unroll
        for (int i = 0; i < 4; ++i) { *(u32x4*)(Zs + (srow + 32 * i) * 144 + sck * 16) = zr[i]; *(u32x4*)(Ys + (srow + 32 * i) * 144 + sck * 16) = yr[i]; }
        __syncthreads();
        if (j == 0) {
#pragma unroll
            for (int i = 0; i < 4; ++i) { zr[i] = *(const u32x4*)(proj + (size_t)(row0 + srow + 32 * i) * N0 + Z_OFF + (g * 4 + hd + 1) * 64 + sck * 8); yr[i] = *(const u32x4*)(conv + (size_t)(row0 + srow + 32 * i) * 2048 + (g * 4 + hd + 1) * 64 + sck * 8); }
        }
        const float wst = __expf(acs[(size_t)lrow * 16 + g * 4 + hd]);
#pragma unroll
        for (int pb = 0; pb < 2; ++pb) {
            f32x16 acc = zero16();
#pragma unroll
            for (int kk = 0; kk < 8; ++kk) { const bf16x8 a = *(const bf16x8*)(lds + hd * 17408 + (32 * pb + r) * 272 + (16 * kk + 8 * hh) * 2); acc = MFMA32(a, cf[kk], acc); }
#pragma unroll
            for (int ig = 0; ig < 4; ++ig) {
                const int off = lr * 144 + (32 * pb + 8 * ig + 4 * hh) * 2;
                const u32x2 yd = *(const u32x2*)(Ys + off), zz = *(const u32x2*)(Zs + off);
                const float ydv[4] = {bflo(yd.x), bfhi(yd.x), bflo(yd.y), bfhi(yd.y)}, zv[4] = {bflo(zz.x), bfhi(zz.x), bflo(zz.y), bfhi(zz.y)};
                float v[4];
#pragma unroll
                for (int t = 0; t < 4; ++t) { v[t] = (ydv[t] + acc[4 * ig + t] * wst) * silu_f(zv[t]); ss += v[t] * v[t]; }
                ypx[j][pb][ig] = pk2(v[0], v[1]); ypy[j][pb][ig] = pk2(v[2], v[3]);
            }
        }
        __syncthreads();
    }
    ss += __shfl_xor(ss, 32);
    if (hh == 0) ssx[wave * 32 + r] = ss;
    __syncthreads();
    const float rstd = rsqrtf((ss + ssx[(wave ^ 4) * 32 + r]) * (1.f / 256.f) + EPS);
    __syncthreads();
    unsigned char* Os = lds;
#pragma unroll
    for (int j = 0; j < 2; ++j)
#pragma unroll
        for (int pb = 0; pb < 2; ++pb)
#pragma unroll
            for (int ig = 0; ig < 4; ++ig) {
                const int col = (2 * grp + j) * 64 + 32 * pb + 8 * ig + 4 * hh;
                const f32x4 nw = *(const f32x4*)(nws + col);
                const unsigned yx = ypx[j][pb][ig], yy = ypy[j][pb][ig];
                u32x2 w; w.x = pk2(bflo(yx) * rstd * nw.x, bfhi(yx) * rstd * nw.y); w.y = pk2(bflo(yy) * rstd * nw.z, bfhi(yy) * rstd * nw.w);
                *(u32x2*)(Os + lr * 528 + col * 2) = w;
            }
    __syncthreads();
#pragma unroll
    for (int i = 0; i < 8; ++i) { const int e = tid + 512 * i, row = e >> 5, ck = e & 31;
        *(u32x4*)(mixed + (size_t)(row0 + row) * 1536 + g * 256 + ck * 8) = *(const u32x4*)(Os + row * 528 + ck * 16); }
    __syncthreads();
}

DI void dil_merge_item4(const bf16_t* og, const float* lse, const bf16_t* proj, bf16_t* mixed, int rowA, int rstep, int lane) {
    const int slot = lane >> 3, ck = lane & 7;
    float lv[4][3]; u32x4 raw[4][3], gr[4];
#pragma unroll
    for (int u = 0; u < 4; ++u) { const int row = (rowA + u * rstep < TS) ? rowA + u * rstep : rowA;
#pragma unroll
        for (int gi = 0; gi < 3; ++gi) { lv[u][gi] = lse[((size_t)gi * TS + row) * 8 + slot]; raw[u][gi] = *(const u32x4*)(og + ((size_t)gi * TS + row) * 512 + slot * 64 + ck * 8); }
        gr[u] = *(const u32x4*)(proj + (size_t)row * N0 + G_OFF + slot * 64 + ck * 8); }
#pragma unroll
    for (int u = 0; u < 4; ++u) {
        const int row = rowA + u * rstep;
        if (row < TS) {
            const float mx = fmaxf(lv[u][0], fmaxf(lv[u][1], lv[u][2]));
            float w[3], wsum = 0.f, o[8];
#pragma unroll
            for (int gi = 0; gi < 3; ++gi) { w[gi] = __expf(lv[u][gi] - mx); wsum += w[gi]; }
            const float inv = __builtin_amdgcn_rcpf(wsum);
#pragma unroll
            for (int j = 0; j < 8; ++j) o[j] = 0.f;
#pragma unroll
            for (int gi = 0; gi < 3; ++gi) { const u32x4 rw = raw[u][gi]; const float ww = w[gi] * inv;
                o[0] += ww * bflo(rw.x); o[1] += ww * bfhi(rw.x); o[2] += ww * bflo(rw.y); o[3] += ww * bfhi(rw.y); o[4] += ww * bflo(rw.z); o[5] += ww * bfhi(rw.z); o[6] += ww * bflo(rw.w); o[7] += ww * bfhi(rw.w); }
            const float gv[8] = {bflo(gr[u].x), bfhi(gr[u].x), bflo(gr[u].y), bfhi(gr[u].y), bflo(gr[u].z), bfhi(gr[u].z), bflo(gr[u].w), bfhi(gr[u].w)};
#pragma unroll
            for (int j = 0; j < 8; ++j) o[j] *= silu_f(gv[j]);
            u32x4 wv; wv.x = pk2(o[0], o[1]); wv.y = pk2(o[2], o[3]); wv.z = pk2(o[4], o[5]); wv.w = pk2(o[6], o[7]);
            *(u32x4*)(mixed + (size_t)row * 1536 + 1024 + slot * 64 + ck * 8) = wv;
        }
    }
}

DI void moba_gate_item(float* kms  , bf16_t* proj, const float* kmean, unsigned* sel, const float* qnw, const float* rope, int item, int lane) {
    const int bh = item >> 6, grp = item & 63, b = bh >> 4, h = bh & 15, t = grp * 64 + lane, ib = grp >> 2;
    {
        const f32x4* kp = (const f32x4*)(kmean + (size_t)bh * 2048);
        f32x4 kv[4], kw[4];
#pragma unroll
        for (int c = 0; c < 4; ++c) { const int e = c * 64 + lane, n = e >> 4, d4 = e & 15; kv[c] = kp[n * 32 + d4]; kw[c] = kp[n * 32 + 16 + d4]; }
#pragma unroll
        for (int c = 0; c < 4; ++c) ((f32x4*)kms)[c * 64 + lane] = (kv[c] + kw[c]) * (1.f / 256.f);
    }
    float qv[64];
    {
        u32x4* qp = (u32x4*)(proj + (size_t)(b * SEQ + t) * N1 + h * 64);
        float ss = 0.f;
#pragma unroll
        for (int c = 0; c < 8; ++c) { const u32x4 raw = qp[c]; qv[8 * c] = bflo(raw.x); qv[8 * c + 1] = bfhi(raw.x); qv[8 * c + 2] = bflo(raw.y); qv[8 * c + 3] = bfhi(raw.y); qv[8 * c + 4] = bflo(raw.z); qv[8 * c + 5] = bfhi(raw.z); qv[8 * c + 6] = bflo(raw.w); qv[8 * c + 7] = bfhi(raw.w); }
#pragma unroll
        for (int j = 0; j < 64; ++j) ss += qv[j] * qv[j];
        const float rn = rsqrtf(ss * (1.f / 64.f) + EPS) * 0.125f;
#pragma unroll
        for (int c = 0; c < 16; ++c) { const f32x4 w4 = *(const f32x4*)(qnw + 4 * c); qv[4 * c] *= rn * w4.x; qv[4 * c + 1] *= rn * w4.y; qv[4 * c + 2] *= rn * w4.z; qv[4 * c + 3] *= rn * w4.w; }
        const f32x4* rp = (const f32x4*)(rope + t * 16);
        const f32x4 c0 = rp[0], c1 = rp[1], s0 = rp[2], s1 = rp[3];
        const float cs[8] = {c0.x, c0.y, c0.z, c0.w, c1.x, c1.y, c1.z, c1.w}, sn[8] = {s0.x, s0.y, s0.z, s0.w, s1.x, s1.y, s1.z, s1.w};
#pragma unroll
        for (int j = 0; j < 8; ++j) { const float x1 = qv[j], x2 = qv[8 + j]; qv[j] = x1 * cs[j] - x2 * sn[j]; qv[8 + j] = x2 * cs[j] + x1 * sn[j]; }
#pragma unroll
        for (int c = 0; c < 8; ++c) { u32x4 w; w.x = pk2(qv[8 * c], qv[8 * c + 1]); w.y = pk2(qv[8 * c + 2], qv[8 * c + 3]); w.z = pk2(qv[8 * c + 4], qv[8 * c + 5]); w.w = pk2(qv[8 * c + 6], qv[8 * c + 7]); qp[c] = w;
            qv[8 * c] = bflo(w.x); qv[8 * c + 1] = bfhi(w.x); qv[8 * c + 2] = bflo(w.y); qv[8 * c + 3] = bfhi(w.y); qv[8 * c + 4] = bflo(w.z); qv[8 * c + 5] = bfhi(w.z); qv[8 * c + 6] = bflo(w.w); qv[8 * c + 7] = bfhi(w.w); }
    }
    LDS_WAIT();
    float v1 = -INFINITY, v2 = -INFINITY, v3 = -INFINITY; int i1 = 255, i2 = 255, i3 = 255;
    for (int n = 0; n < ib; ++n) {
        const f32x4* km = (const f32x4*)(kms + n * 64);
        float d0 = 0.f, d1 = 0.f;
#pragma unroll
        for (int c = 0; c < 16; c += 2) { const f32x4 a = km[c], bq = km[c + 1];
            d0 += (qv[4 * c] * a.x + qv[4 * c + 1] * a.y) + (qv[4 * c + 2] * a.z + qv[4 * c + 3] * a.w);
            d1 += (qv[4 * c + 4] * bq.x + qv[4 * c + 5] * bq.y) + (qv[4 * c + 6] * bq.z + qv[4 * c + 7] * bq.w); }
        const float dot = d0 + d1;
        if (dot > v1) { v3 = v2; i3 = i2; v2 = v1; i2 = i1; v1 = dot; i1 = n; }
        else if (dot > v2) { v3 = v2; i3 = i2; v2 = dot; i2 = n; }
        else if (dot > v3) { v3 = dot; i3 = n; }
    }
    sel[(size_t)bh * SEQ + t] = (unsigned)i1 | ((unsigned)i2 << 8) | ((unsigned)i3 << 16);
    LDS_WAIT();
}
DI void stage_kv(unsigned char* Ks, unsigned char* Vs, const bf16_t* proj, int rowbase, int h, int tid) {
    const int srow = tid >> 3, sck = tid & 7;
    const bf16_t* src = proj + (size_t)(rowbase + srow) * N1 + h * 64 + sck * 8;
    u32x4 pk[4], pv[4];
#pragma unroll
    for (int i = 0; i < 4; ++i) { pk[i] = *(const u32x4*)(src + (size_t)i * 64 * N1 + 1024); pv[i] = *(const u32x4*)(src + (size_t)i * 64 * N1 + 2048); }
#pragma unroll
    for (int i = 0; i < 4; ++i) { *(u32x4*)(Ks + (srow + 64 * i) * 144 + sck * 16) = pk[i]; *(u32x4*)(Vs + (srow + 64 * i) * 144 + sck * 16) = pv[i]; }
}
DI void moba_sel_item(unsigned char* lds, const bf16_t* proj, const unsigned* sel, bf16_t* part01, bf16_t* part2, float* lsep, float smax, int b, int h, int n, int tid, int wave, int lane) {
    const int r = lane & 31, hh = lane >> 5;
    unsigned char* Ks = lds; unsigned char* Vs = lds + 256 * 144;
    unsigned short* list = (unsigned short*)(lds + 2 * 256 * 144); unsigned* cnt = (unsigned*)(lds + 2 * 256 * 144 + 8192);
    __syncthreads();
    if (tid == 0) *cnt = 0u;
    stage_kv(Ks, Vs, proj, b * SEQ + n * 256, h, tid);
    __syncthreads();
    const unsigned* selrow = sel + (size_t)(b * 16 + h) * SEQ;
    {
        unsigned sw[8];
#pragma unroll
        for (int k = 0; k < 8; ++k) { const int c = (n + 1) * 256 + tid + NTHREADS * k; sw[k] = (c < SEQ) ? selrow[c] : 0xFFFFFFFFu; }
#pragma unroll
        for (int k = 0; k < 8; ++k) {
            const int c = (n + 1) * 256 + tid + NTHREADS * k;
            const unsigned s = sw[k];
            const int rho = ((s & 0xFFu) == (unsigned)n) ? 0 : (((s >> 8) & 0xFFu) == (unsigned)n) ? 1 : (((s >> 16) & 0xFFu) == (unsigned)n) ? 2 : -1;
            const unsigned long long mask = __ballot(rho >= 0);
            if (mask != 0ull) {
                unsigned pos0 = 0u;
                if (lane == 0) pos0 = atomicAdd(cnt, (unsigned)__popcll(mask));
                pos0 = (unsigned)__builtin_amdgcn_readfirstlane((int)pos0);
                if (rho >= 0) list[pos0 + (unsigned)__popcll(mask & ((1ull << lane) - 1ull))] = (unsigned short)((c & 0xFFF) | (rho << 12));
            }
        }
    }
    __syncthreads();
    const int total = (int)*cnt;
    bf16x8 qn[4]; unsigned entn = 0u;
    if (32 * wave < total) { const int e = 32 * wave + r; entn = list[e < total ? e : 0];
#pragma unroll
        for (int kk = 0; kk < 4; ++kk) qn[kk] = *(const bf16x8*)(proj + (size_t)(b * SEQ + (entn & 0xFFF)) * N1 + h * 64 + 16 * kk + 8 * hh); }
    for (int k = wave; 32 * k < total; k += NWAVES) {
        const int e = 32 * k + r; const bool valid = e < total;
        const unsigned ent = entn; const int t = ent & 0xFFF, rho = ent >> 12;
        const int qrow = b * SEQ + t;
        bf16x8 qf[4];
#pragma unroll
        for (int kk = 0; kk < 4; ++kk) qf[kk] = qn[kk];
        if (32 * (k + NWAVES) < total) { const int e2 = 32 * (k + NWAVES) + r; entn = list[e2 < total ? e2 : 0];
#pragma unroll
            for (int kk = 0; kk < 4; ++kk) qn[kk] = *(const bf16x8*)(proj + (size_t)(b * SEQ + (entn & 0xFFF)) * N1 + h * 64 + 16 * kk + 8 * hh); }
        float l = 0.f; f32x16 o0 = zero16(), o1 = zero16();
        {
            const float shl = smax * LOG2E;
            f32x16 sa = qk_tile(Ks, 0, qf, lane), sb = qk_tile(Ks, 32, qf, lane);
            bf16x8 pfp[4];
#pragma unroll
            for (int t = 0; t < 4; ++t) {
                f32x16 na = sa, nb = sb;
                if (t < 3) { na = qk_tile(Ks, 64 * t + 64, qf, lane); nb = qk_tile(Ks, 64 * t + 96, qf, lane); }
                bf16x8 pfc[4];
                softmax_exp2t(sa, sb, l, pfc, shl);
                if (t > 0) pv_mfma2t(pfp, o0, o1, Vs, 64 * (t - 1), lane);
                SCHED_MIX(16);
#pragma unroll
                for (int j = 0; j < 4; ++j) pfp[j] = pfc[j];
                sa = na; sb = nb;
            }
            pv_mfma2t(pfp, o0, o1, Vs, 192, lane);
        }
        l += __shfl_xor(l, 32);
        const float inv = 1.f / l;
        if (valid) {
            bf16_t* orow = (rho < 2 ? part01 + (size_t)rho * T * 1024 : part2) + (size_t)qrow * 1024 + h * 64;
#pragma unroll
            for (int ig = 0; ig < 4; ++ig) {
                u32x2 w; w.x = pk2(o0[4 * ig] * inv, o0[4 * ig + 1] * inv); w.y = pk2(o0[4 * ig + 2] * inv, o0[4 * ig + 3] * inv); *(u32x2*)(orow + 8 * ig + 4 * hh) = w;
                w.x = pk2(o1[4 * ig] * inv, o1[4 * ig + 1] * inv); w.y = pk2(o1[4 * ig + 2] * inv, o1[4 * ig + 3] * inv); *(u32x2*)(orow + 32 + 8 * ig + 4 * hh) = w;
            }
            if (hh == 0) lsep[((size_t)rho * T + qrow) * 16 + h] = smax + __logf(l);
        }
    }
}
DI void moba_own_pair(unsigned char* lds, bf16_t* proj, const unsigned* sel, const bf16_t* part01, const bf16_t* part2, const float* lsep, float smax, int b, int h, int iA, int iB, int tid, int wave, int lane) {
    const int r = lane & 31, hh = lane >> 5;
    __syncthreads();
    stage_kv(lds, lds + 256 * 144, proj, b * SEQ + iA * 256, h, tid);
    stage_kv(lds + 2 * 256 * 144, lds + 3 * 256 * 144, proj, b * SEQ + iB * 256, h, tid);
    __syncthreads();
#pragma unroll 1
    for (int sub = 0; sub < 2; ++sub) {
        const int rt = sub ? 7 - wave : wave, ib = sub ? iB : iA;
        const unsigned char* Kc = lds + sub * (2 * 256 * 144); const unsigned char* Vc = Kc + 256 * 144;
        const int qrow = b * SEQ + ib * 256 + 32 * rt + r;
        bf16x8 qf[4];
#pragma unroll
        for (int kk = 0; kk < 4; ++kk) qf[kk] = *(const bf16x8*)(proj + (size_t)qrow * N1 + h * 64 + 16 * kk + 8 * hh);
        const unsigned s = sel[(size_t)(b * 16 + h) * SEQ + ib * 256 + 32 * rt + r];
        float l = 0.f; f32x16 o0 = zero16(), o1 = zero16();
        const int nt = rt + 1;
        int t = 0;
        for (; t + 1 < nt; t += 2) {
            f32x16 sa = qk_tile(Kc, 32 * t, qf, lane), sb = qk_tile(Kc, 32 * t + 32, qf, lane);
            if (t + 1 == rt) mask_le(sb, lane);
            softmax_fs2(sa, sb, l, o0, o1, Vc, 32 * t, lane, smax * LOG2E);
        }
        if (t < nt) { f32x16 sx = qk_tile(Kc, 32 * t, qf, lane); mask_le(sx, lane); softmax_fs1(sx, l, o0, o1, Vc, 32 * t, lane, smax * LOG2E); }
        l += __shfl_xor(l, 32);
        const float lse_own = smax + __logf(l);
        float lv[3]; bool ok[3]; float mx = lse_own;
#pragma unroll
        for (int rho = 0; rho < 3; ++rho) { ok[rho] = ((s >> (8 * rho)) & 0xFFu) != 0xFFu; lv[rho] = ok[rho] ? lsep[((size_t)rho * T + qrow) * 16 + h] : -INFINITY; mx = fmaxf(mx, lv[rho]); }
        float wr[3]; const float wo = __expf(lse_own - mx); float den = wo;
#pragma unroll
        for (int rho = 0; rho < 3; ++rho) { wr[rho] = ok[rho] ? __expf(lv[rho] - mx) : 0.f; den += wr[rho]; }
        const float rden = 1.f / den, so = wo * rden / l;
#pragma unroll
        for (int rho = 0; rho < 3; ++rho) wr[rho] *= rden;
        __syncthreads();
        unsigned char* scr = lds + sub * (2 * 256 * 144) + wave * 9216;
        const int rowb = b * SEQ + ib * 256 + 32 * rt, lr8 = lane >> 3, lck = lane & 7;
        float v[2][4][4];
#pragma unroll
        for (int ig = 0; ig < 4; ++ig)
#pragma unroll
            for (int j = 0; j < 4; ++j) { v[0][ig][j] = o0[4 * ig + j] * so; v[1][ig][j] = o1[4 * ig + j] * so; }
        {
            u32x4 ta[4], tb[4];
#pragma unroll
            for (int j = 0; j < 4; ++j) { const size_t ro = (size_t)(rowb + 8 * j + lr8) * 1024 + h * 64 + lck * 8; ta[j] = *(const u32x4*)(part01 + ro); tb[j] = *(const u32x4*)(part01 + (size_t)T * 1024 + ro); }
#pragma unroll
            for (int j = 0; j < 4; ++j) { *(u32x4*)(scr + (8 * j + lr8) * 136 + lck * 16) = ta[j]; *(u32x4*)(scr + 4352 + (8 * j + lr8) * 136 + lck * 16) = tb[j]; }
            LDS_WAIT();
#pragma unroll
            for (int half = 0; half < 2; ++half)
#pragma unroll
                for (int ig = 0; ig < 4; ++ig) { const int off = r * 136 + (32 * half + 8 * ig + 4 * hh) * 2;
                    const u32x2 p0 = *(const u32x2*)(scr + off), p1 = *(const u32x2*)(scr + 4352 + off);
                    v[half][ig][0] += (ok[0] ? wr[0] * bflo(p0.x) : 0.f) + (ok[1] ? wr[1] * bflo(p1.x) : 0.f); v[half][ig][1] += (ok[0] ? wr[0] * bfhi(p0.x) : 0.f) + (ok[1] ? wr[1] * bfhi(p1.x) : 0.f);
                    v[half][ig][2] += (ok[0] ? wr[0] * bflo(p0.y) : 0.f) + (ok[1] ? wr[1] * bflo(p1.y) : 0.f); v[half][ig][3] += (ok[0] ? wr[0] * bfhi(p0.y) : 0.f) + (ok[1] ? wr[1] * bfhi(p1.y) : 0.f); }
            LDS_WAIT();
        }
        {
            u32x4 ta[4], tb[4];
#pragma unroll
            for (int j = 0; j < 4; ++j) { ta[j] = *(const u32x4*)(part2 + (size_t)(rowb + 8 * j + lr8) * 1024 + h * 64 + lck * 8); tb[j] = *(const u32x4*)(proj + (size_t)(rowb + 8 * j + lr8) * N1 + 3072 + h * 64 + lck * 8); }
#pragma unroll
            for (int j = 0; j < 4; ++j) { *(u32x4*)(scr + (8 * j + lr8) * 136 + lck * 16) = ta[j]; *(u32x4*)(scr + 4352 + (8 * j + lr8) * 136 + lck * 16) = tb[j]; }
            LDS_WAIT();
            u32x2 res[2][4];
#pragma unroll
            for (int half = 0; half < 2; ++half)
#pragma unroll
                for (int ig = 0; ig < 4; ++ig) { const int off = r * 136 + (32 * half + 8 * ig + 4 * hh) * 2;
                    const u32x2 p2 = *(const u32x2*)(scr + off), gg = *(const u32x2*)(scr + 4352 + off);
                    const float a0 = v[half][ig][0] + (ok[2] ? wr[2] * bflo(p2.x) : 0.f), a1 = v[half][ig][1] + (ok[2] ? wr[2] * bfhi(p2.x) : 0.f), a2 = v[half][ig][2] + (ok[2] ? wr[2] * bflo(p2.y) : 0.f), a3 = v[half][ig][3] + (ok[2] ? wr[2] * bfhi(p2.y) : 0.f);
                    res[half][ig].x = pk2(a0 * silu_f(bflo(gg.x)), a1 * silu_f(bfhi(gg.x))); res[half][ig].y = pk2(a2 * silu_f(bflo(gg.y)), a3 * silu_f(bfhi(gg.y))); }
            LDS_WAIT();
#pragma unroll
            for (int half = 0; half < 2; ++half)
#pragma unroll
                for (int ig = 0; ig < 4; ++ig) *(u32x2*)(scr + r * 136 + (32 * half + 8 * ig + 4 * hh) * 2) = res[half][ig];
            LDS_WAIT();
#pragma unroll
            for (int j = 0; j < 4; ++j) *(u32x4*)(proj + (size_t)(rowb + 8 * j + lr8) * N1 + h * 64 + lck * 8) = *(const u32x4*)(scr + (8 * j + lr8) * 136 + lck * 16);
            LDS_WAIT();
        }
    }
}

#define XB_XCNT(j) (64 * (j))
#define XB_XSUB(j) (1024 + 64 * (j))
#define XB_XGEN(j) (2048 + 64 * (j))
#define XB_TOP 3072
#define XB_TOPGEN 3136
#define XB_WORDS 3200
DI unsigned xb_ld(unsigned* p) { return __hip_atomic_load(p, __ATOMIC_RELAXED, __HIP_MEMORY_SCOPE_AGENT); }
DI unsigned xb_add(unsigned* p, unsigned v) { return __hip_atomic_fetch_add(p, v, __ATOMIC_RELAXED, __HIP_MEMORY_SCOPE_AGENT); }
DI unsigned xb_xcc_id() { return (unsigned)__builtin_amdgcn_s_getreg((3 << 11) | 20) & 0xFu; }
#define XB_SPIN(cond) do { unsigned sp_ = 0; while (cond) { __builtin_amdgcn_s_sleep(1); if (++sp_ > (1u << 22)) break; } } while (0)
DI void grid_barrier(unsigned* bar, const volatile unsigned* st, bool leader) {
    asm volatile("s_waitcnt vmcnt(0) lgkmcnt(0)" ::: "memory");
    __syncthreads();
    if (leader) {
        const unsigned x = st[0], nloc = st[1], nx = st[2];
        const unsigned old = xb_add(&bar[XB_XSUB(x)], 1u), gen = old / nloc;
        if (old + 1u == (gen + 1u) * nloc) {
            __builtin_amdgcn_fence(__ATOMIC_RELEASE, "agent");
            asm volatile("s_waitcnt vmcnt(0)" ::: "memory");
            const unsigned og = xb_add(&bar[XB_TOP], 1u), tg = og / nx;
            if (og + 1u == (tg + 1u) * nx) xb_add(&bar[XB_TOPGEN], 1u);
            else XB_SPIN(xb_ld(&bar[XB_TOPGEN]) == tg);
            __builtin_amdgcn_fence(__ATOMIC_ACQUIRE, "agent");
            xb_add(&bar[XB_XGEN(x)], 1u);
            asm volatile("s_waitcnt vmcnt(0)" ::: "memory");
        } else {
            XB_SPIN(xb_ld(&bar[XB_XGEN(x)]) == gen);
            __builtin_amdgcn_fence(__ATOMIC_ACQUIRE, "agent");
            asm volatile("s_waitcnt vmcnt(0)" ::: "memory");
        }
    }
    __syncthreads();
}

DI int lane_id_opaque() { int l; asm volatile("v_mbcnt_lo_u32_b32 %0, -1, 0\n\tv_mbcnt_hi_u32_b32 %0, -1, %0" : "=&v"(l)); return l; }
#define PHASE_BEGIN \
    int tid; asm volatile("v_mbcnt_lo_u32_b32 %0, -1, 0\n\tv_mbcnt_hi_u32_b32 %0, -1, %0" : "=&v"(tid)); tid |= wave0 << 6; \
    const int lane = tid & 63, wave = __builtin_amdgcn_readfirstlane(tid >> 6); \
    int bx = blockIdx.x; asm volatile("" : "+s"(bx)); \
    const int G = gridDim.x, gw = bx * NWAVES + wave, NGW = G * NWAVES; \
    size_t zoff_ = 0; asm volatile("" : "+s"(zoff_));     \
    unsigned char* ws = P.ws + zoff_; \
    unsigned char* dob = (unsigned char*)P.out + zoff_; \
    (void)lane; (void)wave; (void)gw; (void)NGW; (void)G; (void)ws; (void)dob;
#define WSP(type, off) ((type*)(ws + (off)))
#define DOP(type, off) ((type*)(dob + (off)))

__global__ void __launch_bounds__(NTHREADS, 2) fwd_kernel(Params P) {
    extern __shared__ __attribute__((aligned(16))) unsigned char lds[];
    cg::grid_group grid = cg::this_grid();
    const int wave0 = __builtin_amdgcn_readfirstlane((int)threadIdx.x >> 6);
#define TID0() (wave0 == 0 && lane_id_opaque() == 0)
    volatile unsigned* xst = (volatile unsigned*)(lds + LDS_BYTES - 16);
#define GSYNC() grid_barrier((unsigned*)(P.ws + WS_BAR), xst, TID0())
    if (TID0()) xb_add((unsigned*)(P.ws + WS_BAR) + XB_XCNT(xb_xcc_id()), 1u);

    {
        PHASE_BEGIN
        float* scr = (float*)(lds + 65536) + wave * (64 * 33);
        constexpr int I0 = 16 * 256, I1 = 24 * 32, I2 = 16 * 128, I3 = 16 * 32;
        for (int it = gw; it < I0 + I1 + I2 + I3; it += NGW) {
            int q = it;
            if (q < I0) { const int kb = q >> 8, nb = q & 255, n0 = 32 * nb; transpose_item(P.e_w_in, 8208, 1024, WSP(bf16_t, WS_W0T), n0, n0 < 3072 ? n0 : n0 + 16, 64 * kb, P.e_norm_w, scr, lane); continue; } q -= I0;
            if (q < I1) { const int kb = q >> 5, nb = q & 31; transpose_item(P.e_w_out, 1024, 1536, WSP(bf16_t, WS_WO0T), 32 * nb, 32 * nb, 64 * kb, nullptr, scr, lane); continue; } q -= I1;
            if (q < I2) { const int kb = q >> 7, nb = q & 127; transpose_item(P.o_w_in, 4096, 1024, WSP(bf16_t, WS_W1T), 32 * nb, 32 * nb, 64 * kb, P.o_norm_w, scr, lane); continue; } q -= I2;
            { const int kb = q >> 5, nb = q & 31; transpose_item(P.o_w_out, 1024, 1024, WSP(bf16_t, WS_WO1T), 32 * nb, 32 * nb, 64 * kb, nullptr, scr, lane); }
        }
        float* rope = WSP(float, WS_ROPE);
        for (int e = bx * NTHREADS + tid; e < SEQ * 8; e += G * NTHREADS) {
            const int pos = e >> 3, i = e & 7;
            const float inv = powf(500000.f, -(float)i * 0.125f), ang = (float)pos * inv;
            double rev = (double)ang * 0.15915494309189535; rev -= rint(rev);
            const float fr = (float)rev;
            rope[pos * 16 + i] = __builtin_amdgcn_cosf(fr); rope[pos * 16 + 8 + i] = __builtin_amdgcn_sinf(fr);
        }
        f32x4* wl = (f32x4*)lds;
        for (int e = tid; e < 4096; e += NTHREADS) { const int k = e >> 2, c4 = e & 3, l = (k & 255) >> 2, t = k & 3, jj = k >> 8;
            wl[((jj * 4 + t) * 4 + c4) * 64 + l] = *(const f32x4*)(P.e_w_in + (size_t)k * 8208 + 3072 + 4 * c4) * P.e_norm_w[k]; }
        __syncthreads();
        rows_phase<true>(P.x, WSP(bf16_t, WS_XB), WSP(float, WS_RSTD), WSP(float, WS_DTRAW), wl, gw, NGW, lane);
    }
    if (P.ws == nullptr) grid.sync();
    if (TID0()) {
        unsigned* bar = (unsigned*)(P.ws + WS_BAR); const unsigned x = xb_xcc_id(); unsigned mine = 1u, cnt = 0u, sum = 0u, sp = 0u;
        for (;;) { sum = 0u; cnt = 0u;
            for (unsigned j = 0; j < 16; ++j) { const unsigned c = xb_ld(&bar[XB_XCNT(j)]); sum += c; cnt += (c > 0u) ? 1u : 0u; if (j == x) mine = c; }
            if (sum == gridDim.x || ++sp > (1u << 22)) break; __builtin_amdgcn_s_sleep(1); }
        xst[0] = x; xst[1] = mine ? mine : 1u; xst[2] = cnt ? cnt : 1u;
    }
    GSYNC();

    for (int sl = 0; sl < 2; ++sl) {
        const size_t R0 = (size_t)sl * TS;
        {
            PHASE_BEGIN
            pg8::Gemm g{WSP(bf16_t, WS_XB) + R0 * D, WSP(bf16_t, WS_W0T), TS, N0, D, D, D}; pg8::StaticOrder S; S.init(TS, N0, G, bx);
            pg8::EpiScaleBf16 E{WSP(bf16_t, WS_PROJ), N0, WSP(float, WS_RSTD) + R0, nullptr};
            pg8::gemm_phase<pg8::EpiScaleBf16, pg8::StaticOrder>((LAS unsigned char*)lds, g, S, E, tid);
        }
        GSYNC();
        {
            PHASE_BEGIN
            constexpr int IB = 512 * 4, IC = 512;
            for (int q = gw; q < IB; q += NGW) conv_item(WSP(bf16_t, WS_PROJ), DOP(bf16_t, DO_CONV), P.e_conv_w, P.e_conv_b, (q >> 2) * 16, (q & 3) * 512, lane);
            if ((gw & 3) == 0) for (int q = gw >> 2; q < IC; q += (NGW + 3) >> 2)
                dt_item(WSP(float, WS_DTRAW) + R0 * 16, DOP(float, DO_DT), DOP(float, DO_ACS), P.e_dt_bias, P.e_a_log, q, lane);
        }
        GSYNC();
        {
            PHASE_BEGIN
            const int nrd = (512 + 768 + G - 1) / G;
            for (int r5 = 0; r5 < nrd; ++r5) {
                const int it = bx + G * ((r5 + (bx >> 5)) % nrd);
                if (it >= 512 + 768) continue;
                if (it < 512) { const int xq = it & 7, rest = it >> 3, X = xq + 8 * (rest >> 2), hd4 = rest & 3;
                    ssd_intra_item(lds, DOP(bf16_t, DO_CONV), DOP(float, DO_DT), DOP(float, DO_ACS), WSP(float, WS_STATES), P.e_d_skip, (X >> 2) * 16 + (X & 3) * 4 + hd4, tid, wave, lane); }
                else { const int d = it - 512, gi = d >> 8, w8 = d & 255, xq = w8 & 7, rest = w8 >> 3, tps = 16 >> (2 * gi);
                    dil_attn_item(lds, WSP(bf16_t, WS_PROJ), DOP(bf16_t, DO_OG), DOP(float, DO_LSE), P.e_q_norm, P.e_k_norm, WSP(float, WS_ROPE), (gi << 8) + (xq + 8 * (rest / tps)) * tps + (rest & (tps - 1)), tid, wave, lane); }
            }
        }
        GSYNC();
        {
            PHASE_BEGIN
            float* states = WSP(float, WS_STATES); const float* acs = DOP(float, DO_ACS);
            typedef float f32x2v __attribute__((ext_vector_type(2)));
            for (int e = bx * NTHREADS + tid; e < 32 * 4096; e += G * NTHREADS) {
                const int bh = e >> 12, idx = e & 4095, bl = bh >> 4, h = bh & 15;
                float* base = states + (size_t)(bl * 256 + h) * 8192 + (size_t)idx * 2;
                f32x2v sv[15]; float av[15];
#pragma unroll
                for (int c = 0; c < 15; ++c) { sv[c] = *(const f32x2v*)(base + (size_t)c * 16 * 8192); av[c] = acs[(size_t)(bl * SEQ + c * 256 + 255) * 16 + h]; }
                f32x2v E = (f32x2v){0.f, 0.f};
#pragma unroll
                for (int c = 0; c < 15; ++c) { const float dec = __expf(av[c]); E = E * dec + sv[c]; *(f32x2v*)(base + (size_t)(c + 1) * 16 * 8192) = E; }
            }
        }
        GSYNC();
        {
            PHASE_BEGIN
            bf16_t* mixed = WSP(bf16_t, WS_MIXED) + R0 * 1536;
            if (bx & 1) for (int row = gw; row < TS; row += 4 * NGW) dil_merge_item4(DOP(bf16_t, DO_OG), DOP(float, DO_LSE), WSP(bf16_t, WS_PROJ), mixed, row, NGW, lane);
            for (int it = bx; it < 256; it += G) { const int xq = it & 7, rest = it >> 3, X = xq + 8 * (rest >> 1), h2 = rest & 1;
                ssd_final_item(lds, DOP(bf16_t, DO_CONV), WSP(bf16_t, WS_PROJ), mixed, DOP(float, DO_ACS), WSP(float, WS_STATES), P.e_ssd_norm_w, (X >> 2) * 8 + h2 * 4 + (X & 3), tid, wave, lane); }
            if (!(bx & 1)) for (int row = gw; row < TS; row += 4 * NGW) dil_merge_item4(DOP(bf16_t, DO_OG), DOP(float, DO_LSE), WSP(bf16_t, WS_PROJ), mixed, row, NGW, lane);
        }
        GSYNC();
    }
    {
        PHASE_BEGIN
        pg8::Gemm g{WSP(bf16_t, WS_MIXED), WSP(bf16_t, WS_WO0T), T, 1024, 1536, 1536, 1536}; pg8::StaticOrder S; S.init(T, 1024, G, bx);
        pg8::EpiResF32X E{P.x, (float*)dob, WSP(bf16_t, WS_XB), WSP(float, WS_DTRAW), 1024};
        pg8::gemm_phase<pg8::EpiResF32X, pg8::StaticOrder>((LAS unsigned char*)lds, g, S, E, tid);
    }
    GSYNC();
    {
        PHASE_BEGIN
        pg8::Gemm g{WSP(bf16_t, WS_XB), WSP(bf16_t, WS_W1T), T, N1, D, D, D}; pg8::StaticOrder S; S.init(T, N1, G, bx);
        pg8::EpiScaleBf16 E{WSP(bf16_t, WS_PROJ), N1, nullptr, WSP(float, WS_DTRAW)};
        pg8::gemm_phase<pg8::EpiScaleBf16, pg8::StaticOrder>((LAS unsigned char*)lds, g, S, E, tid);
    }
    GSYNC();
    {
        PHASE_BEGIN
        for (int it = gw; it < 2048; it += NGW) { const int half = it & 1, rb = it >> 5, hd = (it >> 1) & 15;
            qk_norm_rope_item(WSP(bf16_t, WS_PROJ), N1, rb * 256 + half * 128, 4, 1024 + hd * 64, P.o_k_norm, 1.f, WSP(float, WS_ROPE), WSP(float, WS_KMEAN) + (size_t)((((rb >> 4) * 16 + hd) * 16 + (rb & 15)) * 2 + half) * 64, lane); }
    }
    GSYNC();
    {
        PHASE_BEGIN
        for (int it = gw; it < 4096; it += NGW) moba_gate_item((float*)(lds + wave * 4096), WSP(bf16_t, WS_PROJ), WSP(float, WS_KMEAN), WSP(unsigned, WS_W0T + (4u << 20)), P.o_q_norm, WSP(float, WS_ROPE), it, lane);
    }
    GSYNC();
    {
        PHASE_BEGIN
        const float smax1 = score_bound(P.o_q_norm, P.o_k_norm, lane);
        for (int it = bx; it < 1024; it += G) {
            const int rd = it >> 8, c = it & 255, qd = c >> 6, bh = c & 63, n = 4 * rd + ((rd & 1) ? 3 - qd : qd);
            if (n < 15) moba_sel_item(lds, WSP(bf16_t, WS_PROJ), WSP(unsigned, WS_W0T + (4u << 20)), WSP(bf16_t, WS_MIXED), WSP(bf16_t, WS_XB), WSP(float, WS_W0T), smax1, bh >> 4, bh & 15, n, tid, wave, lane);
        }
    }
    GSYNC();
    {
        PHASE_BEGIN
        const float smax1 = score_bound(P.o_q_norm, P.o_k_norm, lane);
        for (int it = bx; it < 512; it += G) {
            const int bh = it & 63, j = it >> 6;
            moba_own_pair(lds, WSP(bf16_t, WS_PROJ), WSP(unsigned, WS_W0T + (4u << 20)), WSP(bf16_t, WS_MIXED), WSP(bf16_t, WS_XB), WSP(float, WS_W0T), smax1, bh >> 4, bh & 15, 2 * j, 2 * j + 1, tid, wave, lane);
        }
    }
    GSYNC();
    {
        PHASE_BEGIN
        pg8::Gemm g{WSP(bf16_t, WS_PROJ), WSP(bf16_t, WS_WO1T), T, 1024, 1024, N1, 1024}; pg8::StaticOrder S; S.init(T, 1024, G, bx);
        pg8::EpiResF32 E{(const float*)dob, (float*)dob, 1024};
        pg8::gemm_phase<pg8::EpiResF32, pg8::StaticOrder>((LAS unsigned char*)lds, g, S, E, tid);
    }
}

extern "C" void kernel_launch(void* const* d_in, const int* in_sizes, int n_in, void* d_out, int out_size, void* d_ws, size_t ws_size, hipStream_t stream) {
    static int grid = 0;
    if (grid == 0) {
        if (n_in != 17 || in_sizes[0] != T * D || out_size != T * D || ws_size < WS_END) { fprintf(stderr, "kernel_launch: unexpected shapes (n_in %d, in0 %d, out %d, ws %zu < %zu)\n", n_in, n_in > 0 ? in_sizes[0] : -1, out_size, ws_size, (size_t)WS_END); grid = -1; return; }
        int dev = 0, cus = 0, per_cu = 0;
        hipGetDevice(&dev);
        hipDeviceGetAttribute(&cus, hipDeviceAttributeMultiprocessorCount, dev);
        if (hipFuncSetAttribute((const void*)fwd_kernel, hipFuncAttributeMaxDynamicSharedMemorySize, LDS_BYTES) != hipSuccess) { fprintf(stderr, "kernel_launch: hipFuncSetAttribute failed\n"); grid = -1; return; }
        if (hipOccupancyMaxActiveBlocksPerMultiprocessor(&per_cu, (const void*)fwd_kernel, NTHREADS, LDS_BYTES) != hipSuccess || per_cu < 1) { fprintf(stderr, "kernel_launch: occupancy query gives %d\n", per_cu); per_cu = 1; }
        (void)hipGetLastError();
        grid = cus * 1;
    }
    if (grid < 0) return;
    if (hipMemsetAsync((unsigned char*)d_ws + WS_BAR, 0, 3200 * 4, stream) != hipSuccess) { fprintf(stderr, "kernel_launch: memset failed\n"); return; }
    Params p{};
    const float** pp = (const float**)&p;
    for (int i = 0; i < 17; ++i) pp[i] = (const float*)d_in[i];
    p.out = (float*)d_out; p.ws = (unsigned char*)d_ws;
    void* args[] = {&p};
    hipError_t e = hipLaunchCooperativeKernel((const void*)fwd_kernel, dim3(grid), dim3(NTHREADS), args, LDS_BYTES, stream);
    if (e != hipSuccess) fprintf(stderr, "cooperative launch failed: %s (grid %d)\n", hipGetErrorString(e), grid);
}
```
